# Optimizing an MI355X kernel written in HIP

```python
import jax, jax.numpy as jnp
from jax import lax
import numpy as np

D_MODEL = 1024
BATCH = 2
SEQ = 8192
DEPTH = 1
DEC_BATCH = 16
DEC_SEQ = 64
PAST_LEN = 4096

CHUNK = 64
GMLP_CHUNK = 128
GMLP_WIDTH = 1024
GMLP_GROUPS = 8
GMLP_GROUP_DIM = GMLP_WIDTH // GMLP_GROUPS
SSM_INNER = 2 * D_MODEL
SSM_HEAD_DIM = 64
SSM_HEADS = SSM_INNER // SSM_HEAD_DIM
SSM_GROUPS = 4
SSM_HEADS_PER_GROUP = SSM_HEADS // SSM_GROUPS
SSM_STATE = 128
CONV_WIDTH = 4
CONV_DIM = SSM_INNER + 2 * SSM_GROUPS * SSM_STATE
FFN_HIDDEN = 4 * D_MODEL
IN_DIM = 2 * GMLP_WIDTH + SSM_INNER + CONV_DIM + SSM_HEADS + 2 * D_MODEL
EPS = 1e-6

kernel_name = "streaming_gmlp_ssd_hybrid_step"


def rms_norm(x, w):
    xf = x.astype(jnp.float32)
    y = xf * lax.rsqrt(jnp.mean(xf * xf, axis=-1, keepdims=True) + EPS)
    return (y * w.astype(jnp.float32)).astype(x.dtype)


def layer_norm(x, w, b):
    xf = x.astype(jnp.float32)
    mu = jnp.mean(xf, axis=-1, keepdims=True)
    xc = xf - mu
    var = jnp.mean(xc * xc, axis=-1, keepdims=True)
    return (xc * lax.rsqrt(var + EPS) * w.astype(jnp.float32) + b.astype(jnp.float32)).astype(x.dtype)


def gated_group_rms_norm(y, z, w):
    g = y.astype(jnp.float32) * jax.nn.silu(z.astype(jnp.float32))
    g = g.reshape(g.shape[:-1] + (SSM_GROUPS, SSM_INNER // SSM_GROUPS))
    g = g * lax.rsqrt(jnp.mean(g * g, axis=-1, keepdims=True) + EPS)
    return (g.reshape(y.shape) * w.astype(jnp.float32)).astype(y.dtype)


def causal_conv(xbc, hist, w, b):
    L = xbc.shape[1]
    xp = jnp.concatenate([hist.astype(xbc.dtype), xbc], axis=1)
    out = b
    for k in range(CONV_WIDTH):
        out = out + xp[:, k:k + L] * w[k]
    return jax.nn.silu(out), xp[:, -(CONV_WIDTH - 1):]


def gmlp_spatial(v, ws, bs):
    bsz, L, _ = v.shape
    n = min(L, GMLP_CHUNK)
    pos = jnp.arange(n)
    mask = (pos[None, :] // CHUNK) <= (pos[:, None] // CHUNK)
    w = jnp.where(mask[None], ws[:, :n, :n], 0.0).astype(v.dtype)
    vc = v.reshape(bsz, L // n, n, GMLP_GROUPS, GMLP_GROUP_DIM)
    out = jnp.einsum('gij,bcjgd->bcigd', w, vc) + bs[:, :n].T[None, None, :, :, None].astype(v.dtype)
    return out.reshape(bsz, L, GMLP_WIDTH)


def ssd(x, dt, a, bmat, cmat, h0, q):
    bsz, L = x.shape[:2]
    nc = L // q
    G, R, P, N = SSM_GROUPS, SSM_HEADS_PER_GROUP, SSM_HEAD_DIM, SSM_STATE
    x = x.reshape(bsz, nc, q, G, R, P)
    dt = dt.reshape(bsz, nc, q, G, R)
    bm = bmat.reshape(bsz, nc, q, G, N)
    cm = cmat.reshape(bsz, nc, q, G, N)
    acum = jnp.cumsum(dt * a.reshape(G, R), axis=2)
    idx = jnp.arange(q)
    causal = (idx[:, None] >= idx[None, :])[None, None, :, :, None, None]
    seg = acum[:, :, :, None] - acum[:, :, None, :]
    decay = jnp.exp(jnp.where(causal, seg, -jnp.inf))
    xdt = x * dt[..., None]
    cb = jnp.einsum('bcign,bcjgn->bcijg', cm, bm)
    y_diag = jnp.einsum('bcijgr,bcjgrp->bcigrp', cb[..., None] * decay, xdt)
    last = acum[:, :, -1]
    to_end = jnp.exp(last[:, :, None] - acum)
    chunk_states = jnp.einsum('bcjgn,bcjgrp->bcgrpn', bm, to_end[..., None] * xdt)

    def step(h, inp):
        dec, s = inp
        return h * jnp.exp(dec)[..., None, None] + s, h

    h_last, h_prev = lax.scan(step, h0.reshape(bsz, G, R, P, N),
                              (jnp.moveaxis(last, 1, 0), jnp.moveaxis(chunk_states, 1, 0)))
    h_prev = jnp.moveaxis(h_prev, 0, 1)
    y_off = jnp.einsum('bcign,bcgrpn->bcigrp', cm, h_prev) * jnp.exp(acum)[..., None]
    y = (y_diag + y_off).reshape(bsz, L, SSM_HEADS, P)
    return y, h_last.reshape(bsz, SSM_HEADS, P, N)


def hybrid_layer(x, conv_hist, h0, ssd_q, pre_mix_w, w_in, gmlp_ln_w, gmlp_ln_b, gmlp_ws, gmlp_bs,
                 conv_w, conv_b, dt_bias, a_log, d_skip, ssm_norm_w, w_branch_a, w_branch_b, w_out,
                 post_mix_w, pre_ffn_w, w_up, w_down, post_ffn_w):
    bsz, L, _ = x.shape
    h = rms_norm(x, pre_mix_w)
    proj = h @ w_in
    p1 = GMLP_WIDTH
    p2 = p1 + GMLP_WIDTH
    p3 = p2 + SSM_INNER
    p4 = p3 + CONV_DIM
    p5 = p4 + SSM_HEADS
    p6 = p5 + D_MODEL
    u, v, z, xbc, dt_raw, g_a, g_b = jnp.split(proj, [p1, p2, p3, p4, p5, p6], axis=-1)
    u = jax.nn.gelu(u)
    v = layer_norm(jax.nn.gelu(v), gmlp_ln_w, gmlp_ln_b)
    o_a = u * gmlp_spatial(v, gmlp_ws, gmlp_bs)
    xbc, conv_state = causal_conv(xbc, conv_hist, conv_w, conv_b)
    xs, bm, cm = jnp.split(xbc, [SSM_INNER, SSM_INNER + SSM_GROUPS * SSM_STATE], axis=-1)
    dt = jax.nn.softplus(dt_raw.astype(jnp.float32) + dt_bias.astype(jnp.float32))
    a = -jnp.exp(a_log.astype(jnp.float32))
    xs4 = xs.reshape(bsz, L, SSM_HEADS, SSM_HEAD_DIM).astype(jnp.float32)
    y, h_last = ssd(xs4, dt, a,
                    bm.reshape(bsz, L, SSM_GROUPS, SSM_STATE).astype(jnp.float32),
                    cm.reshape(bsz, L, SSM_GROUPS, SSM_STATE).astype(jnp.float32),
                    h0.astype(jnp.float32), ssd_q)
    y = (y + d_skip.astype(jnp.float32)[:, None] * xs4).reshape(bsz, L, SSM_INNER).astype(x.dtype)
    o_b = gated_group_rms_norm(y, z, ssm_norm_w)
    merged = jax.nn.sigmoid(g_a) * (o_a @ w_branch_a) + jax.nn.sigmoid(g_b) * (o_b @ w_branch_b)
    x = x + rms_norm(merged @ w_out, post_mix_w)
    f = jnp.square(jax.nn.relu(rms_norm(x, pre_ffn_w) @ w_up)) @ w_down
    x = x + rms_norm(f, post_ffn_w)
    return x, conv_state, h_last.astype(h0.dtype), v


def setup_inputs(seed: int = 0) -> dict:
    key = jax.random.key(seed)
    ks = jax.random.split(key, 32)
    nrm = lambda k, shape, s: jax.random.normal(k, shape, jnp.float32) * s
    dt0 = jnp.exp(jax.random.uniform(ks[10], (DEPTH, SSM_HEADS), jnp.float32)
                  * (np.log(0.1) - np.log(0.001)) + np.log(0.001))
    return {
        "x_prompt": nrm(ks[0], (BATCH, SEQ, D_MODEL), 1.0),
        "x_sample": nrm(ks[1], (DEC_BATCH, DEC_SEQ, D_MODEL), 1.0),
        "cache_conv": nrm(ks[2], (DEPTH, DEC_BATCH, CONV_WIDTH - 1, CONV_DIM), 1.0),
        "state_ssm": nrm(ks[3], (DEPTH, DEC_BATCH, SSM_HEADS, SSM_HEAD_DIM, SSM_STATE), 0.1),
        "pre_mix_w": 1.0 + nrm(ks[4], (DEPTH, D_MODEL), 0.02),
        "w_in": nrm(ks[5], (DEPTH, D_MODEL, IN_DIM), D_MODEL ** -0.5),
        "gmlp_ln_w": 1.0 + nrm(ks[6], (DEPTH, GMLP_WIDTH), 0.02),
        "gmlp_ln_b": nrm(ks[7], (DEPTH, GMLP_WIDTH), 0.02),
        "gmlp_ws": nrm(ks[8], (DEPTH, GMLP_GROUPS, GMLP_CHUNK, GMLP_CHUNK), GMLP_CHUNK ** -0.5),
        "gmlp_bs": 1.0 + nrm(ks[9], (DEPTH, GMLP_GROUPS, GMLP_CHUNK), 0.02),
        "conv_w": nrm(ks[11], (DEPTH, CONV_WIDTH, CONV_DIM), CONV_WIDTH ** -0.5),
        "conv_b": nrm(ks[12], (DEPTH, CONV_DIM), 0.01),
        "dt_bias": dt0 + jnp.log(-jnp.expm1(-dt0)),
        "a_log": jnp.log(jax.random.uniform(ks[13], (DEPTH, SSM_HEADS), jnp.float32, 1.0, 16.0)),
        "d_skip": 1.0 + nrm(ks[14], (DEPTH, SSM_HEADS), 0.1),
        "ssm_norm_w": 1.0 + nrm(ks[15], (DEPTH, SSM_INNER), 0.02),
        "w_branch_a": nrm(ks[16], (DEPTH, GMLP_WIDTH, D_MODEL), GMLP_WIDTH ** -0.5),
        "w_branch_b": nrm(ks[17], (DEPTH, SSM_INNER, D_MODEL), SSM_INNER ** -0.5),
        "w_out": nrm(ks[18], (DEPTH, D_MODEL, D_MODEL), D_MODEL ** -0.5),
        "post_mix_w": 1.0 + nrm(ks[19], (DEPTH, D_MODEL), 0.02),
        "pre_ffn_w": 1.0 + nrm(ks[20], (DEPTH, D_MODEL), 0.02),
        "w_up": nrm(ks[21], (DEPTH, D_MODEL, FFN_HIDDEN), D_MODEL ** -0.5),
        "w_down": nrm(ks[22], (DEPTH, FFN_HIDDEN, D_MODEL), FFN_HIDDEN ** -0.5),
        "post_ffn_w": 1.0 + nrm(ks[23], (DEPTH, D_MODEL), 0.02),
    }


def reference(x_prompt, x_sample, cache_conv, state_ssm, pre_mix_w, w_in, gmlp_ln_w, gmlp_ln_b,
              gmlp_ws, gmlp_bs, conv_w, conv_b, dt_bias, a_log, d_skip, ssm_norm_w, w_branch_a,
              w_branch_b, w_out, post_mix_w, pre_ffn_w, w_up, w_down, post_ffn_w):
    yp, ys = x_prompt, x_sample
    conv_hist0 = jnp.zeros((x_prompt.shape[0], CONV_WIDTH - 1, CONV_DIM), x_prompt.dtype)
    h00 = jnp.zeros((x_prompt.shape[0], SSM_HEADS, SSM_HEAD_DIM, SSM_STATE), state_ssm.dtype)
    conv_p, ssm_p, conv_s, ssm_s, v_s = [], [], [], [], []
    for l in range(DEPTH):
        lw = (pre_mix_w[l], w_in[l], gmlp_ln_w[l], gmlp_ln_b[l], gmlp_ws[l], gmlp_bs[l], conv_w[l],
              conv_b[l], dt_bias[l], a_log[l], d_skip[l], ssm_norm_w[l], w_branch_a[l], w_branch_b[l],
              w_out[l], post_mix_w[l], pre_ffn_w[l], w_up[l], w_down[l], post_ffn_w[l])
        yp, cp, sp, _ = hybrid_layer(yp, conv_hist0, h00, CHUNK, *lw)
        ys, cs, ss, vs = hybrid_layer(ys, cache_conv[l], state_ssm[l], x_sample.shape[1], *lw)
        conv_p.append(cp)
        ssm_p.append(sp)
        conv_s.append(cs)
        ssm_s.append(ss)
        v_s.append(vs)
    return (yp, ys, jnp.stack(conv_p), jnp.stack(ssm_p), jnp.stack(conv_s), jnp.stack(ssm_s), jnp.stack(v_s))
```

```cpp
#include <hip/hip_runtime.h>
#include <hip/hip_cooperative_groups.h>
#include <cstdio>
#include <cstdint>
namespace cg = cooperative_groups;
namespace pg8 {
#define PG8_LAS __attribute__((address_space(3)))
typedef unsigned short bf16_t;
typedef short bf16x8 __attribute__((ext_vector_type(8)));
typedef float f32x4 __attribute__((ext_vector_type(4)));
typedef unsigned u32x4 __attribute__((ext_vector_type(4)));
constexpr int BM = 256, BK = 64, HALF = 128, HTB = HALF * BK * 2  , STAGE_BYTES = 8 * HTB, NXCD = 8, WGM = 8;

__host__ __device__ __forceinline__ int lds_byte(int r, int c) { const int st = (r >> 4) * 2 + (c >> 5), rr = r & 15, cc = c & 31, ob = rr * 64 + cc * 2; return st * 1024 + (ob ^ (((ob >> 9) & 1) << 5)); }
__host__ __device__ __forceinline__ void stage_rc(int b, int& R, int& C) { const int st = b / 1024, sb = b % 1024, swz = sb ^ (((sb >> 9) & 1) << 5); R = (st >> 1) * 16 + swz / 64; C = (st & 1) * 32 + (swz % 64) / 2; }
__host__ __device__ __forceinline__ int perm32(int rho) { const int n = rho >> 4, i = rho & 15; return 8 * (i >> 2) + 4 * n + (i & 3); }

struct Unit { int pm, pn, kb, nk; };
struct Gemm { const bf16_t* A; const bf16_t* Bt; int M, N, K; };

struct StaticOrder {
    int nM, nN, nwg, G, c;
    __host__ __device__ void init(int M, int N, int G_, int c_) { nM = M / BM; nN = N / BM; nwg = nM * nN; G = G_; c = c_; }
    __host__ __device__ bool next(int i, Unit& u) const {
        const long L = (long)i * G + c; if (L >= nwg) return false;
        int wgid = (int)L; { const int q = nwg / NXCD, r = nwg % NXCD, xcd = wgid % NXCD, off = wgid / NXCD; wgid = (xcd < r ? xcd * (q + 1) : r * (q + 1) + (xcd - r) * q) + off; }
        const int nig = WGM * nN, gid = wgid / nig, fm = gid * WGM, gsz = (nM - fm) < WGM ? (nM - fm) : WGM;
        u.pm = fm + ((wgid % nig) % gsz); u.pn = (wgid % nig) / gsz; u.kb = 0; u.nk = 0; return true;
    }
    __device__ __forceinline__ void a_ready(const Unit&) const {}
    __device__ __forceinline__ void done(const Unit&) const {}
};
struct InOrder {
    StaticOrder so; int np, G, cx;
    __host__ __device__ void init(int M, int N, int G_, int c_) { so.init(M, N, G_, c_); np = c_ < so.nwg ? (so.nwg - c_ + G_ - 1) / G_ : 0; G = G_; cx = (c_ - (so.nwg % G_) + G_) % G_; }
    __host__ __device__ bool next(int i, Unit& u) const {
        if (i < np) return so.next(i, u);
        const int l = (i - np) * G + cx; if (l >= 32) return false;
        u.pm = 64 + (l >> 3); u.pn = 29 + (l & 7); u.kb = 0; u.nk = 0; return true;
    }
    __device__ __forceinline__ void a_ready(const Unit&) const {}
    __device__ __forceinline__ void done(const Unit&) const {}
};
struct TailOrder {
    StaticOrder so; int np, n, G, c, log_ns, nk, gate, cx;
    __host__ __device__ void init(int log_ns_, int nk_, int G_, int c_, int gate_ = 0, int coff = 0) { cx = (c_ - coff % G_ + G_) % G_; so.init(64 * BM, 4 * BM, G_, c_); np = c_ < so.nwg ? (so.nwg - c_ + G_ - 1) / G_ : 0; log_ns = log_ns_; nk = nk_; n = gate_ ? 0 : (16 << log_ns_); G = G_; c = c_; gate = gate_; if (gate_) np *= 2; }
    __host__ __device__ bool next(int i, Unit& u) const {
        if (i < np) { if (!gate) return so.next(i, u); const bool ok = so.next(i >> 1, u); u.pn += 4 * (i & 1); return ok; }
        const int l = (i - np) * G + cx; if (l >= n) return false;
        u.kb = (l & ((1 << log_ns) - 1)) * (nk * BK * 2); u.nk = nk; const int t = l >> log_ns; u.pn = t & 3; u.pm = 64 + (t >> 2); return true;
    }
    __device__ __forceinline__ void a_ready(const Unit&) const {}
    __device__ __forceinline__ void done(const Unit&) const {}
};

__device__ __forceinline__ unsigned cvt_pk_bf16(float lo, float hi) { unsigned r; asm volatile("v_cvt_pk_bf16_f32 %0, %1, %2" : "=v"(r) : "v"(lo), "v"(hi)); return r; }
typedef float f32x2 __attribute__((ext_vector_type(2)));
template <class Epi, class Sched, bool ALIGN_EPI = false, bool SP2 = false>
__device__ __forceinline__ void gemm_phase(PG8_LAS unsigned char* lds, const Gemm g, const Sched& S, const Epi& E) {
    int tid_ = threadIdx.x; asm volatile("" : "+v"(tid_));
    const int tid = tid_, wid = __builtin_amdgcn_readfirstlane(tid >> 6), lane = tid & 63, wr = wid >> 2, wc = wid & 3, fr = lane & 15, fq = lane >> 4;
    const int K = g.K, ntfull = K / BK;
    unsigned voffA[2], voffB[2];
#pragma unroll
    for (int i = 0; i < 2; ++i) { int R, C; stage_rc(tid * 16 + i * 8192, R, C); const int Rb = Epi::PERM ? ((R & ~31) + perm32(R & 31)) : R;
        voffA[i] = (unsigned)(R * K + C) * 2u; voffB[i] = (unsigned)(Rb * K + C) * 2u; }
    const size_t kstep = (size_t)(BK * 2);
    const size_t hstep = (size_t)HALF * K * 2;
    const size_t tstep = 2 * hstep;
    const unsigned ldsw = (unsigned)wid * 1024u;
    const int aoff = lds_byte(wr * 64 + fr, fq * 8), boff = lds_byte(wc * 32 + fr, fq * 8);
#define PG8_SA(b, h) (((b) * 2 + (h)) * HTB)
#define PG8_SB(b, h) ((4 + (b) * 2 + (h)) * HTB)
#define PG8_STAGE(bufoff, gbase, voff) do { _Pragma("unroll") for (int _i = 0; _i < 2; ++_i) \
        __builtin_amdgcn_global_load_lds((const unsigned*)((const char*)(gbase) + (voff)[_i]), (PG8_LAS unsigned*)(lds + (bufoff) + ldsw + _i * 8192), 16, 0, 0); } while (0)
#define PG8_LDA(dst, b, h) do { _Pragma("unroll") for (int m = 0; m < 4; ++m) _Pragma("unroll") for (int k = 0; k < 2; ++k) dst[m][k] = *(const PG8_LAS bf16x8*)(lds + PG8_SA(b, h) + aoff + m * 2048 + k * 1024); } while (0)
#define PG8_LDB(dst, b, h) do { _Pragma("unroll") for (int n = 0; n < 2; ++n) _Pragma("unroll") for (int k = 0; k < 2; ++k) dst[n][k] = *(const PG8_LAS bf16x8*)(lds + PG8_SB(b, h) + boff + n * 2048 + k * 1024); } while (0)
#define PG8_MMA(ai, bj, At, Bt) do { __builtin_amdgcn_s_setprio(1); _Pragma("unroll") for (int m = 0; m < 4; ++m) _Pragma("unroll") for (int n = 0; n < 2; ++n) _Pragma("unroll") for (int k = 0; k < 2; ++k) \
        acc[ai][bj][m][n] = __builtin_amdgcn_mfma_f32_16x16x32_bf16(Bt[n][k], At[m][k], acc[ai][bj][m][n], 0, 0, 0); __builtin_amdgcn_s_setprio(0); } while (0)
#define PG8_WAIT_V(n) asm volatile("s_waitcnt vmcnt(" #n ")" ::: "memory")
#define PG8_WAIT_L(n) asm volatile("s_waitcnt lgkmcnt(" #n ")" ::: "memory")
#define PG8_BAR __builtin_amdgcn_s_barrier()
#define PG8_SCHED __builtin_amdgcn_sched_barrier(0)
    Unit cur, nxt; int ui = 0;
    if (!S.next(0, cur)) return;
    f32x4 acc[2][2][4][2];
#pragma unroll
    for (int a = 0; a < 2; ++a)
#pragma unroll
        for (int b = 0; b < 2; ++b)
#pragma unroll
            for (int m = 0; m < 4; ++m)
#pragma unroll
                for (int n = 0; n < 2; ++n) acc[a][b][m][n] = (f32x4){0.f, 0.f, 0.f, 0.f};
    bf16x8 At[4][2], B0[2][2], B1[2][2];
    const char* cA = (const char*)g.A + (size_t)cur.pm * tstep + cur.kb; const char* cB = (const char*)g.Bt + (size_t)cur.pn * tstep + cur.kb;
    S.a_ready(cur);
    if constexpr (SP2) {
        PG8_STAGE(PG8_SB(0, 0), cB, voffB); PG8_STAGE(PG8_SB(0, 1), cB + hstep, voffB); PG8_STAGE(PG8_SA(0, 0), cA, voffA); PG8_STAGE(PG8_SA(0, 1), cA + hstep, voffA);
        if (wr == 1) PG8_BAR;
        PG8_WAIT_V(2); PG8_BAR;
        PG8_STAGE(PG8_SB(1, 0), cB + kstep, voffB); PG8_STAGE(PG8_SA(1, 0), cA + kstep, voffA); PG8_STAGE(PG8_SB(1, 1), cB + hstep + kstep, voffB);
        PG8_WAIT_V(6); PG8_BAR;
    } else {
        PG8_STAGE(PG8_SB(0, 0), cB, voffB); PG8_STAGE(PG8_SA(0, 0), cA, voffA); PG8_STAGE(PG8_SB(0, 1), cB + hstep, voffB); PG8_STAGE(PG8_SA(0, 1), cA + hstep, voffA);
        if (wr == 1) PG8_BAR;
        PG8_WAIT_V(4); PG8_BAR;
        PG8_STAGE(PG8_SB(1, 0), cB + kstep, voffB); PG8_STAGE(PG8_SA(1, 0), cA + kstep, voffA); PG8_STAGE(PG8_SB(1, 1), cB + hstep + kstep, voffB);
        PG8_WAIT_V(6); PG8_BAR;
    }
    for (;;) {
        const bool has_next = S.next(ui + 1, nxt);
        const char* nA = has_next ? (const char*)g.A + (size_t)nxt.pm * tstep + nxt.kb : cA; const char* nB = has_next ? (const char*)g.Bt + (size_t)nxt.pn * tstep + nxt.kb : cB;
        const int nt = cur.nk ? cur.nk : ntfull;
        for (int t = 0; t < nt; t += 2) {
            const bool last = (t == nt - 2);
            const char* a1 = cA + (size_t)(t + 1) * kstep;
            const char* a2 = last ? nA : cA + (size_t)(t + 2) * kstep; const char* b2 = last ? nB : cB + (size_t)(t + 2) * kstep;
            const char* a3 = a2 + kstep; const char* b3 = b2 + kstep;
            if (last && has_next) S.a_ready(nxt);
            if constexpr (SP2) {
            PG8_LDB(B0, 0, 0); PG8_LDB(B1, 0, 1); PG8_SCHED; PG8_LDA(At, 0, 0); PG8_STAGE(PG8_SA(1, 1), a1 + hstep, voffA);
            PG8_WAIT_V(8); PG8_WAIT_L(0); PG8_BAR; PG8_MMA(0, 0, At, B0); PG8_MMA(0, 1, At, B1); PG8_BAR; PG8_SCHED;
            PG8_LDA(At, 0, 1); PG8_STAGE(PG8_SB(0, 0), b2, voffB); PG8_STAGE(PG8_SB(0, 1), b2 + hstep, voffB); PG8_STAGE(PG8_SA(0, 0), a2, voffA);
            PG8_WAIT_V(8); PG8_WAIT_L(0); PG8_BAR; PG8_MMA(1, 0, At, B0); PG8_MMA(1, 1, At, B1); PG8_BAR; PG8_SCHED;
            PG8_LDB(B0, 1, 0); PG8_LDB(B1, 1, 1); PG8_SCHED; PG8_LDA(At, 1, 0); PG8_STAGE(PG8_SA(0, 1), a2 + hstep, voffA);
            PG8_WAIT_V(8); PG8_WAIT_L(0); PG8_BAR; PG8_MMA(0, 0, At, B0); PG8_MMA(0, 1, At, B1); PG8_BAR; PG8_SCHED;
            PG8_LDA(At, 1, 1); PG8_STAGE(PG8_SB(1, 0), b3, voffB); PG8_STAGE(PG8_SB(1, 1), b3 + hstep, voffB); PG8_STAGE(PG8_SA(1, 0), a3, voffA);
            PG8_WAIT_V(8); PG8_WAIT_L(0); PG8_BAR; PG8_MMA(1, 0, At, B0); PG8_MMA(1, 1, At, B1); PG8_BAR; PG8_SCHED;
            } else {
            PG8_LDB(B0, 0, 0); PG8_SCHED; PG8_LDA(At, 0, 0); PG8_STAGE(PG8_SA(1, 1), a1 + hstep, voffA);
            PG8_WAIT_L(8); PG8_BAR; PG8_WAIT_L(0); PG8_MMA(0, 0, At, B0); PG8_BAR; PG8_SCHED;
            PG8_LDB(B1, 0, 1); PG8_STAGE(PG8_SB(0, 0), b2, voffB);
            PG8_BAR; PG8_WAIT_L(0); PG8_MMA(0, 1, At, B1); PG8_BAR;
            PG8_LDA(At, 0, 1); PG8_STAGE(PG8_SA(0, 0), a2, voffA);
            PG8_BAR; PG8_WAIT_L(0); PG8_MMA(1, 0, At, B0); PG8_BAR; PG8_SCHED;
            PG8_STAGE(PG8_SB(0, 1), b2 + hstep, voffB);
            PG8_WAIT_V(6); PG8_BAR; PG8_MMA(1, 1, At, B1); PG8_BAR;
            PG8_LDB(B0, 1, 0); PG8_SCHED; PG8_LDA(At, 1, 0); PG8_STAGE(PG8_SA(0, 1), a2 + hstep, voffA);
            PG8_WAIT_L(8); PG8_BAR; PG8_WAIT_L(0); PG8_MMA(0, 0, At, B0); PG8_BAR; PG8_SCHED;
            PG8_LDB(B1, 1, 1); PG8_STAGE(PG8_SB(1, 0), b3, voffB);
            PG8_BAR; PG8_WAIT_L(0); PG8_MMA(0, 1, At, B1); PG8_BAR;
            PG8_LDA(At, 1, 1); PG8_STAGE(PG8_SA(1, 0), a3, voffA);
            PG8_BAR; PG8_WAIT_L(0); PG8_MMA(1, 0, At, B0); PG8_BAR; PG8_SCHED;
            PG8_STAGE(PG8_SB(1, 1), b3 + hstep, voffB);
            PG8_WAIT_V(6); PG8_BAR; PG8_MMA(1, 1, At, B1); PG8_BAR;
            }
        }
        if constexpr (ALIGN_EPI) { if (wr == 0) PG8_BAR; }
        if constexpr (!Epi::AFTER_DRAIN) { E(acc, cur, wr, wc, fr, fq); S.done(cur); }
        if (!has_next) break;
#pragma unroll
        for (int a = 0; a < 2; ++a)
#pragma unroll
            for (int b = 0; b < 2; ++b)
#pragma unroll
                for (int m = 0; m < 4; ++m)
#pragma unroll
                    for (int n = 0; n < 2; ++n) acc[a][b][m][n] = (f32x4){0.f, 0.f, 0.f, 0.f};
        cur = nxt; cA = nA; cB = nB; ++ui;
        if constexpr (ALIGN_EPI) { if (wr == 1) PG8_BAR; }
    }
    PG8_WAIT_V(0);
    if constexpr (!ALIGN_EPI) { if (wr == 0) PG8_BAR; }
    PG8_BAR;
    if constexpr (Epi::AFTER_DRAIN) { E.fused(acc, cur, wr, wc, fr, fq, lds, wid, lane); S.done(cur); }
#undef PG8_SA
#undef PG8_SB
#undef PG8_STAGE
#undef PG8_LDA
#undef PG8_LDB
#undef PG8_MMA
#undef PG8_WAIT_V
#undef PG8_WAIT_L
#undef PG8_BAR
#undef PG8_SCHED
}
}

#ifndef MK_LAUNCHES
#define MK_LAUNCHES 1
#endif
#define LAS __attribute__((address_space(3)))
typedef unsigned short bf16;
using pg8::bf16x8; using pg8::f32x4; using pg8::u32x4; using pg8::Unit;
typedef __bf16 bf16x2_t __attribute__((ext_vector_type(2)));
typedef float f32x2_t __attribute__((ext_vector_type(2)));
__device__ __forceinline__ unsigned cvt_pk_bf16(float lo, float hi) { const f32x2_t f = {lo, hi}; const bf16x2_t b = __builtin_convertvector(f, bf16x2_t); return __builtin_bit_cast(unsigned, b); }
typedef unsigned u32x2 __attribute__((ext_vector_type(2)));
typedef float f32x2v __attribute__((ext_vector_type(2)));

constexpr int NT = 512;
constexpr int D = 1024, MP = 16384, MS = 1024, M = MP + MS, FF = 4096;
constexpr int NIN = 9248;
constexpr float EPS = 1e-6f;
constexpr int LDS_BYTES = 147456;
constexpr size_t O_CP = 17825792, O_SP = 17844224, O_CS = 18368512, O_SS = 18515968, O_VS = 22710272;
constexpr size_t HM = 512 * 1024;
constexpr size_t SH = 1032192;
constexpr size_t WS_WIN = 2 * HM - SH, WS_WA = 39 * HM - SH, WS_WB = 43 * HM - SH, WS_WO = 51 * HM - SH, WS_WUP = 55 * HM - SH, WS_WDN = 71 * HM - SH;
constexpr size_t WS_XN = 87 * HM - SH, WS_U = 155 * HM - SH, WS_G = 223 * HM - SH, WS_XBC = 291 * HM - SH;
constexpr size_t WS_VST = 495 * HM - SH, WS_DT = WS_VST + 2228224, WS_CD = WS_DT + 2228224, WS_ST = WS_CD + 8192, WS_ST2 = WS_ST  , WS_END = 512 * HM;
constexpr size_t WS_GABS = 504 * HM;
static_assert(WS_ST + 1114112 <= WS_GABS && WS_WIN == 16384, "tail of the d_ws map");
constexpr size_t WS_S = WS_G, WS_GAB = 223 * HM - SH, WS_T = 359 * HM - SH, WS_MG = WS_XN, WS_T2 = 223 * HM - SH, WS_X1N = 359 * HM - SH, WS_H = 87 * HM - SH, WS_F = 359 * HM - SH;
constexpr size_t WS_SLA = 427 * HM - SH, WS_SLB = 443 * HM - SH;
constexpr size_t WS_ACO = 427 * HM - SH, WS_ACF = 423 * HM - SH;

struct KP { const float* in[24]; float* out; unsigned char* ws; int ph_lo, ph_hi; };
enum { I_XP = 0, I_XS, I_CACHE, I_STATE, I_PREMIX, I_WIN, I_LNW, I_LNB, I_GWS, I_GBS, I_CONVW, I_CONVB, I_DTB, I_ALOG, I_DSKIP, I_SNW, I_WA, I_WB, I_WO, I_POSTMIX, I_PREFFN, I_WUP, I_WDN, I_POSTFFN };

__device__ __forceinline__ float bflo(unsigned w) { return __uint_as_float(w << 16); }
__device__ __forceinline__ float bfhi(unsigned w) { return __uint_as_float(w & 0xffff0000u); }
__device__ __forceinline__ float bf1(unsigned short b) { return __uint_as_float((unsigned)b << 16); }
__device__ __forceinline__ float fsigmoid(float x) { return __builtin_amdgcn_rcpf(1.f + __expf(-x)); }
__device__ __forceinline__ float fsilu(float x) { return x * fsigmoid(x); }
__device__ __forceinline__ float fgelu(float x) { const float t = x * (1.5957691216f + 0.0713548163f * x * x); return x * __builtin_amdgcn_rcpf(1.f + __expf(-t)); }
__device__ __forceinline__ float wave_sum(float v) {
#pragma unroll
    for (int o = 1; o < 64; o <<= 1) v += __shfl_xor(v, o);
    return v;
}
__device__ __forceinline__ u32x4 pack8(const float (&a)[8]) { u32x4 w; w.x = cvt_pk_bf16(a[0], a[1]); w.y = cvt_pk_bf16(a[2], a[3]); w.z = cvt_pk_bf16(a[4], a[5]); w.w = cvt_pk_bf16(a[6], a[7]); return w; }
__device__ __forceinline__ void unpack8(const u32x4 w, float (&a)[8]) { a[0] = bflo(w.x); a[1] = bfhi(w.x); a[2] = bflo(w.y); a[3] = bfhi(w.y); a[4] = bflo(w.z); a[5] = bfhi(w.z); a[6] = bflo(w.w); a[7] = bfhi(w.w); }
__device__ __forceinline__ const float* xrow(const KP& p, int m) { return m < MP ? p.in[I_XP] + (size_t)m * D : p.in[I_XS] + (size_t)(m - MP) * D; }

#define EPI_ROWS_BEGIN _Pragma("unroll") for (int ai = 0; ai < 2; ++ai) _Pragma("unroll") for (int m = 0; m < 4; ++m) { const int row = u.pm * 256 + ai * 128 + wr * 64 + m * 16 + fr;
#define EPI_COLS_BEGIN _Pragma("unroll") for (int bj = 0; bj < 2; ++bj) { const int col = u.pn * 256 + bj * 128 + wc * 32 + 8 * fq; \
        float v[8]; { const f32x4 v0 = acc[ai][bj][m][0], v1 = acc[ai][bj][m][1]; v[0] = v0[0]; v[1] = v0[1]; v[2] = v0[2]; v[3] = v0[3]; v[4] = v1[0]; v[5] = v1[1]; v[6] = v1[2]; v[7] = v1[3]; }
#define EPI_END }
typedef const f32x4 (&AccRef)[2][2][4][2];

struct EpiUV {
    static constexpr bool PERM = true, AFTER_DRAIN = false; bf16* U; bf16* G; f32x2v* VST;
    __device__ __forceinline__ void operator()(AccRef acc, const Unit& u, int wr, int wc, int fr, int fq) const {
        const bool isv = u.pn >= 4; bf16* base = isv ? G : U;
        EPI_ROWS_BEGIN float s = 0.f, s2 = 0.f;
            EPI_COLS_BEGIN
#pragma unroll
                for (int e = 0; e < 8; ++e) { v[e] = fgelu(v[e]); s += v[e]; s2 += v[e] * v[e]; }
                *(u32x4*)(base + (size_t)row * 1024 + (col & 1023)) = pack8(v);
            EPI_END
            if (isv) { s += __shfl_xor(s, 16); s += __shfl_xor(s, 32); s2 += __shfl_xor(s2, 16); s2 += __shfl_xor(s2, 32);
                if (fq == 0) VST[(size_t)row * 16 + (u.pn - 4) * 4 + wc] = (f32x2v){s, s2}; }
        EPI_END
    }
};
struct EpiZXD {
    static constexpr bool PERM = true, AFTER_DRAIN = false; bf16* Z; bf16* XBC; float* DT; const float* dtb; float* out;
    __device__ __forceinline__ void operator()(AccRef acc, const Unit& u, int wr, int wc, int fr, int fq) const {
        EPI_ROWS_BEGIN
            EPI_COLS_BEGIN
                if (u.pn < 8) {
#pragma unroll
                    for (int e = 0; e < 8; ++e) v[e] = fsilu(v[e]);
                    *(u32x4*)(Z + (size_t)row * 2048 + col) = pack8(v);
                } else if (u.pn < 20) {
                    const int c = col - 2048;
                    *(u32x4*)(XBC + (size_t)row * 3072 + c) = pack8(v);
                    int k; size_t o;
                    if (row < MP) { k = (row & 8191) - 8189; o = O_CP + ((size_t)(row >> 13) * 3 + k) * 3072 + c; }
                    else { k = ((row - MP) & 63) - 61; o = O_CS + ((size_t)((row - MP) >> 6) * 3 + k) * 3072 + c; }
                    if (k >= 0) { *(f32x4*)(out + o) = (f32x4){v[0], v[1], v[2], v[3]}; *(f32x4*)(out + o + 4) = (f32x4){v[4], v[5], v[6], v[7]}; }
                } else if (bj == 0 && wc == 0) {
                    int c = 8 * fq; asm volatile("" : "+v"(c));
#pragma unroll
                    for (int e = 0; e < 8; ++e) { const float x = v[e] + dtb[c + e]; v[e] = x > 15.f ? x : log1pf(__expf(x)); }
                    *(f32x4*)(DT + (size_t)row * 32 + c) = (f32x4){v[0], v[1], v[2], v[3]}; *(f32x4*)(DT + (size_t)row * 32 + c + 4) = (f32x4){v[4], v[5], v[6], v[7]};
                }
            EPI_END
        EPI_END
    }
};
struct EpiG {
    static constexpr bool PERM = true, AFTER_DRAIN = false; bf16* GAB; int roff;
    __device__ __forceinline__ void operator()(AccRef acc, const Unit& u, int wr, int wc, int fr, int fq) const {
        EPI_ROWS_BEGIN EPI_COLS_BEGIN
#pragma unroll
            for (int e = 0; e < 8; ++e) v[e] = fsigmoid(v[e]);
            *(u32x4*)(GAB + (size_t)(row - roff) * 2048 + col) = pack8(v);
        EPI_END EPI_END
    }
};
struct EpiIn {
    static constexpr bool PERM = true, AFTER_DRAIN = false; EpiUV uv; EpiZXD zxd; EpiG gs;
    __device__ __forceinline__ void operator()(AccRef acc, const Unit& u, int wr, int wc, int fr, int fq) const {
        if (u.pn < 8) uv(acc, u, wr, wc, fr, fq);
        else if (u.pn < 29) { Unit v = u; v.pn = u.pn - 8; zxd(acc, v, wr, wc, fr, fq); }
        else { Unit v = u; v.pn = u.pn - 29; gs(acc, v, wr, wc, fr, fq); }
    }
};
struct EpiA {
    static constexpr bool PERM = true, AFTER_DRAIN = false; const bf16* GAB; const bf16* GABS; bf16* T;
    __device__ __forceinline__ void operator()(AccRef acc, const Unit& u, int wr, int wc, int fr, int fq) const {
        EPI_ROWS_BEGIN EPI_COLS_BEGIN
            float s[8]; unpack8(*(const u32x4*)((row < MP ? GAB + (size_t)row * 2048 : GABS + (size_t)(row - MP) * 2048) + col), s);
#pragma unroll
            for (int e = 0; e < 8; ++e) v[e] *= s[e];
            *(u32x4*)(T + (size_t)row * 1024 + col) = pack8(v);
        EPI_END EPI_END
    }
};
struct EpiB {
    static constexpr bool PERM = true, AFTER_DRAIN = false; const bf16* GAB; const bf16* GABS; const bf16* T; bf16* MG;
    __device__ __forceinline__ void operator()(AccRef acc, const Unit& u, int wr, int wc, int fr, int fq) const {
        EPI_ROWS_BEGIN EPI_COLS_BEGIN
            float s[8], t[8]; unpack8(*(const u32x4*)((row < MP ? GAB + (size_t)row * 2048 : GABS + (size_t)(row - MP) * 2048) + 1024 + col), s); unpack8(*(const u32x4*)(T + (size_t)row * 1024 + col), t);
#pragma unroll
            for (int e = 0; e < 8; ++e) v[e] = t[e] + s[e] * v[e];
            *(u32x4*)(MG + (size_t)row * 1024 + col) = pack8(v);
        EPI_END EPI_END
    }
};

struct EpiSq {
    static constexpr bool PERM = true, AFTER_DRAIN = false; bf16* O; float* ST;
    __device__ __forceinline__ void operator()(AccRef acc, const Unit& u, int wr, int wc, int fr, int fq) const {
        EPI_ROWS_BEGIN float s2 = 0.f;
            EPI_COLS_BEGIN
#pragma unroll
                for (int e = 0; e < 8; ++e) s2 += v[e] * v[e];
                *(u32x4*)(O + (size_t)row * 1024 + col) = pack8(v);
            EPI_END
            s2 += __shfl_xor(s2, 16); s2 += __shfl_xor(s2, 32);
            if (fq == 0) ST[(size_t)row * 16 + u.pn * 4 + wc] = s2;
        EPI_END
    }
};
struct EpiSqTail {
    static constexpr bool PERM = true, AFTER_DRAIN = false; EpiSq sq; float* SL; int kb_shift;
    __device__ __forceinline__ void operator()(AccRef acc, const Unit& u, int wr, int wc, int fr, int fq) const {
        if (u.nk == 0) { sq(acc, u, wr, wc, fr, fq); return; }
        float* base = SL + (size_t)(u.kb >> kb_shift) * (MS * D);
        EPI_ROWS_BEGIN EPI_COLS_BEGIN
            float* t = base + (size_t)(row - MP) * 1024 + col;
            *(f32x4*)t = (f32x4){v[0], v[1], v[2], v[3]}; *(f32x4*)(t + 4) = (f32x4){v[4], v[5], v[6], v[7]};
        EPI_END EPI_END
    }
};
struct EpiGen {
    static constexpr bool PERM = true, AFTER_DRAIN = false; int mode; const bf16* GAB; const bf16* T; bf16* O; float* ST; float* SL; int kb_shift;
    __device__ __forceinline__ void operator()(AccRef acc, const Unit& u, int wr, int wc, int fr, int fq) const {
        if (u.nk != 0) {
            float* base = SL + (size_t)(u.kb >> kb_shift) * (MS * D);
            EPI_ROWS_BEGIN EPI_COLS_BEGIN
                float* t = base + (size_t)(row - MP) * 1024 + col;
                *(f32x4*)t = (f32x4){v[0], v[1], v[2], v[3]}; *(f32x4*)(t + 4) = (f32x4){v[4], v[5], v[6], v[7]};
            EPI_END EPI_END
            return;
        }
        if (mode == 2) {
            EPI_ROWS_BEGIN float s2 = 0.f;
                EPI_COLS_BEGIN
#pragma unroll
                    for (int e = 0; e < 8; ++e) s2 += v[e] * v[e];
                    *(u32x4*)(O + (size_t)row * 1024 + col) = pack8(v);
                EPI_END
                s2 += __shfl_xor(s2, 16); s2 += __shfl_xor(s2, 32);
                if (fq == 0) ST[(size_t)row * 16 + u.pn * 4 + wc] = s2;
            EPI_END
            return;
        }
        if (mode == 3) {
            EPI_ROWS_BEGIN EPI_COLS_BEGIN
#pragma unroll
                for (int e = 0; e < 8; ++e) v[e] = fsigmoid(v[e]);
                *(u32x4*)(O + (size_t)row * 2048 + col) = pack8(v);
            EPI_END EPI_END
            return;
        }
        const int goff = mode ? 1024 : 0;
        EPI_ROWS_BEGIN EPI_COLS_BEGIN
            float s[8]; unpack8(*(const u32x4*)(GAB + (size_t)row * 2048 + goff + col), s);
            if (mode) { float t[8]; unpack8(*(const u32x4*)(T + (size_t)row * 1024 + col), t);
#pragma unroll
                for (int e = 0; e < 8; ++e) v[e] = t[e] + s[e] * v[e]; }
            else {
#pragma unroll
                for (int e = 0; e < 8; ++e) v[e] *= s[e]; }
            *(u32x4*)(O + (size_t)row * 1024 + col) = pack8(v);
        EPI_END EPI_END
    }
};
struct EpiUp {
    static constexpr bool PERM = true, AFTER_DRAIN = false; bf16* H;
    __device__ __forceinline__ void operator()(AccRef acc, const Unit& u, int wr, int wc, int fr, int fq) const {
        EPI_ROWS_BEGIN EPI_COLS_BEGIN
#pragma unroll
            for (int e = 0; e < 8; ++e) { const float r = fmaxf(v[e], 0.f); v[e] = r * r; }
            *(u32x4*)(H + (size_t)row * FF + col) = pack8(v);
        EPI_END EPI_END
    }
};

__device__ __forceinline__ void tr_item(const float* W, int K, int N, bf16* WT, const float* scale, bool winmap, LAS float* scr, int item, int lane) {
    const int nblk = N / 32, kb = item / nblk, nb = item % nblk, k0 = 64 * kb, n0 = 32 * nb;
    float wv[32];
#pragma unroll
    for (int i = 0; i < 32; ++i) wv[i] = __builtin_nontemporal_load(W + (size_t)(k0 + 2 * i + (lane >> 5)) * N + n0 + (lane & 31));
#pragma unroll
    for (int i = 0; i < 32; ++i) { const int kk = 2 * i + (lane >> 5); float v = wv[i]; if (scale) v *= scale[k0 + kk]; scr[kk * 33 + (lane & 31)] = v; }
    asm volatile("s_waitcnt lgkmcnt(0)" ::: "memory");
    const int c = lane & 7; const int rbase = (winmap && n0 >= 7200) ? n0 + 224 : n0;
#pragma unroll
    for (int j = 0; j < 4; ++j) { const int n = (lane >> 3) + 8 * j; const LAS float* s = scr + (8 * c) * 33 + n;
        u32x4 o; o.x = cvt_pk_bf16(s[0 * 33], s[1 * 33]); o.y = cvt_pk_bf16(s[2 * 33], s[3 * 33]); o.z = cvt_pk_bf16(s[4 * 33], s[5 * 33]); o.w = cvt_pk_bf16(s[6 * 33], s[7 * 33]);
        *(u32x4*)(WT + (size_t)(rbase + n) * K + k0 + 8 * c) = o; }
    asm volatile("s_waitcnt lgkmcnt(0)" ::: "memory");
}
__device__ __forceinline__ void phase_prologue(const KP& p, LAS unsigned char* lds, int wid, int lane, int part, int gw_ = -1, int ngw_ = 0) {
    LAS float* scr = (LAS float*)(lds + wid * 16384);
    const int gw = gw_ >= 0 ? gw_ : blockIdx.x * 8 + wid, NGW = gw_ >= 0 ? ngw_ : gridDim.x * 8;
    constexpr int I_IN = 16 * 289, I_A = 16 * 32, I_B = 32 * 32, I_O = 16 * 32, I_UP = 16 * 128, I_DN = 64 * 32;
    constexpr int NITEMS = I_IN + I_A + I_B + I_O + I_UP + I_DN;
    unsigned char* ws = p.ws;
#pragma clang loop unroll(disable)
    for (int it = (part ? I_IN : 0) + gw; it < (part ? NITEMS : I_IN); it += NGW) {
        int r = it; const float* W; int K, N; bf16* WT; const float* sc = nullptr; bool wm = false;
        if (r < I_IN) { W = p.in[I_WIN]; K = D; N = NIN; WT = (bf16*)(ws + WS_WIN); sc = p.in[I_PREMIX]; wm = true; }
        else if ((r -= I_IN) < I_A) { W = p.in[I_WA]; K = D; N = D; WT = (bf16*)(ws + WS_WA); }
        else if ((r -= I_A) < I_B) { W = p.in[I_WB]; K = 2048; N = D; WT = (bf16*)(ws + WS_WB); }
        else if ((r -= I_B) < I_O) { W = p.in[I_WO]; K = D; N = D; WT = (bf16*)(ws + WS_WO); }
        else if ((r -= I_O) < I_UP) { W = p.in[I_WUP]; K = D; N = FF; WT = (bf16*)(ws + WS_WUP); sc = p.in[I_PREFFN]; }
        else { r -= I_UP; W = p.in[I_WDN]; K = FF; N = D; WT = (bf16*)(ws + WS_WDN); }
        tr_item(W, K, N, WT, sc, wm, scr, r, lane);
    }
    if (part) return;
    bf16* XN = (bf16*)(ws + WS_XN);
    for (int m = gw; m < M; m += NGW) {
        const f32x4* xr = (const f32x4*)xrow(p, m) + lane; f32x4 v[4]; float s = 0.f;
#pragma unroll
        for (int j = 0; j < 4; ++j) { v[j] = __builtin_nontemporal_load(xr + 64 * j); s += (v[j][0] * v[j][0] + v[j][1] * v[j][1]) + (v[j][2] * v[j][2] + v[j][3] * v[j][3]); }
        const float r = rsqrtf(wave_sum(s) * (1.f / D) + EPS);
        u32x2* o = (u32x2*)(XN + (size_t)m * D) + lane;
#pragma unroll
        for (int j = 0; j < 4; ++j) { u32x2 w; w.x = cvt_pk_bf16(v[j][0] * r, v[j][1] * r); w.y = cvt_pk_bf16(v[j][2] * r, v[j][3] * r); o[64 * j] = w; }
    }
}

__device__ __forceinline__ void gmlp_unit(const KP& p, LAS unsigned char* lds, int ck, int g, int tid, int wid, int lane, bool dry = false) {
    LAS bf16* Wl = (LAS bf16*)lds;
    LAS bf16* Vt = (LAS bf16*)(lds + 34816);
    LAS f32x2v* RS = (LAS f32x2v*)(lds + 69632);
    const bool sample = ck >= 128; const int nrows = sample ? 64 : 128; const int row0 = sample ? MP + (ck - 128) * 64 : ck * 128;
    bf16* U = (bf16*)(p.ws + WS_U); const bf16* G = (const bf16*)(p.ws + WS_G); const f32x2v* VST = (const f32x2v*)(p.ws + WS_VST);
    const float* Wg = p.in[I_GWS] + (size_t)g * 16384;
#pragma unroll
    for (int it = 0; it < 8; ++it) { const int idx = tid + it * NT; const int i = idx >> 5, j4 = (idx & 31) * 4; const f32x4 w = *(const f32x4*)(Wg + i * 128 + j4);
        u32x2 o; o.x = cvt_pk_bf16(w[0], w[1]); o.y = cvt_pk_bf16(w[2], w[3]); *(LAS u32x2*)(Wl + i * 136 + j4) = o; }
    if (tid < nrows) { const f32x2v* s = VST + (size_t)(row0 + tid) * 16; float a = 0.f, b = 0.f;
#pragma unroll
        for (int t = 0; t < 16; ++t) { const f32x2v x = s[t]; a += x.x; b += x.y; }
        const float mean = a * (1.f / 1024.f); const float var = fmaxf(b * (1.f / 1024.f) - mean * mean, 0.f); RS[tid] = (f32x2v){mean, rsqrtf(var + EPS)}; }
    __syncthreads();
    for (int it = tid; it < nrows * 16; it += NT) { const int j = it >> 4, d8 = (it & 15) * 8; const int c = g * 128 + d8;
        float x[8]; unpack8(*(const u32x4*)(G + (size_t)(row0 + j) * 1024 + c), x);
        const f32x2v rs = RS[j]; const f32x4 w0 = *(const f32x4*)(p.in[I_LNW] + c), w1 = *(const f32x4*)(p.in[I_LNW] + c + 4), b0 = *(const f32x4*)(p.in[I_LNB] + c), b1 = *(const f32x4*)(p.in[I_LNB] + c + 4);
        const float lw[8] = {w0[0], w0[1], w0[2], w0[3], w1[0], w1[1], w1[2], w1[3]}, lb[8] = {b0[0], b0[1], b0[2], b0[3], b1[0], b1[1], b1[2], b1[3]};
#pragma unroll
        for (int e = 0; e < 8; ++e) { x[e] = (x[e] - rs.x) * rs.y * lw[e] + lb[e]; Vt[(d8 + e) * 136 + j] = (bf16)(cvt_pk_bf16(x[e], 0.f) & 0xffffu); }
        if (sample && !dry) { float* o = p.out + O_VS + ((size_t)(ck - 128) * 64 + j) * 1024 + c; *(f32x4*)o = (f32x4){x[0], x[1], x[2], x[3]}; *(f32x4*)(o + 4) = (f32x4){x[4], x[5], x[6], x[7]}; }
    }
    __syncthreads();
    const int fr = lane & 15, q = lane >> 4; const int ibl = wid >> 1, ds0 = (wid & 1) * 4;
    f32x4 alo[4], ahi[4];
#pragma unroll
    for (int d = 0; d < 4; ++d) { alo[d] = (f32x4){0.f, 0.f, 0.f, 0.f}; ahi[d] = (f32x4){0.f, 0.f, 0.f, 0.f}; }
#pragma unroll
    for (int ks = 0; ks < 4; ++ks) {
        if (ks >= 2 && sample) break;
        bf16x8 X[4];
#pragma unroll
        for (int d = 0; d < 4; ++d) X[d] = *(const LAS bf16x8*)(Vt + ((ds0 + d) * 16 + fr) * 136 + ks * 32 + 8 * q);
        if (ks < 2) { const bf16x8 Y = *(const LAS bf16x8*)(Wl + (ibl * 16 + fr) * 136 + ks * 32 + 8 * q);
#pragma unroll
            for (int d = 0; d < 4; ++d) alo[d] = __builtin_amdgcn_mfma_f32_16x16x32_bf16(X[d], Y, alo[d], 0, 0, 0); }
        if (!sample) { const bf16x8 Y = *(const LAS bf16x8*)(Wl + ((4 + ibl) * 16 + fr) * 136 + ks * 32 + 8 * q);
#pragma unroll
            for (int d = 0; d < 4; ++d) ahi[d] = __builtin_amdgcn_mfma_f32_16x16x32_bf16(X[d], Y, ahi[d], 0, 0, 0); }
    }
#pragma unroll
    for (int hh = 0; hh < 2; ++hh) {
        if (hh == 1 && sample) break;
        const int i = (hh * 4 + ibl) * 16 + fr; const float bsv = p.in[I_GBS][g * 128 + i];
#pragma unroll
        for (int d = 0; d < 4; ++d) { const f32x4 a = hh ? ahi[d] : alo[d]; bf16* up = U + (size_t)(row0 + i) * 1024 + g * 128 + (ds0 + d) * 16 + 4 * q;
            const u32x2 uu = *(const u32x2*)up; u32x2 o; o.x = cvt_pk_bf16(bflo(uu.x) * (a[0] + bsv), bfhi(uu.x) * (a[1] + bsv)); o.y = cvt_pk_bf16(bflo(uu.y) * (a[2] + bsv), bfhi(uu.y) * (a[3] + bsv));
            if (!dry) *(u32x2*)up = o; }
    }
    __syncthreads();
}

__device__ __forceinline__ u32x4 ssd_load8(const KP& p, const bf16* XBC, int seq, int rowbase, int trel, int ch) {
    if (trel >= 0) return *(const u32x4*)(XBC + (size_t)(rowbase + trel) * 3072 + ch);
    if (seq >= 2) { const float* h = p.in[I_CACHE] + ((size_t)(seq - 2) * 3 + (trel + 3)) * 3072 + ch; const f32x4 a = *(const f32x4*)h, b = *(const f32x4*)(h + 4);
        return (u32x4){cvt_pk_bf16(a[0], a[1]), cvt_pk_bf16(a[2], a[3]), cvt_pk_bf16(b[0], b[1]), cvt_pk_bf16(b[2], b[3])}; }
    return (u32x4){0u, 0u, 0u, 0u};
}
__device__ __forceinline__ u32x2 ld8_agent(const bf16* q) { const unsigned long long v = __hip_atomic_load((const unsigned long long*)q, __ATOMIC_RELAXED, __HIP_MEMORY_SCOPE_AGENT); return (u32x2){(unsigned)v, (unsigned)(v >> 32)}; }
__device__ __forceinline__ void st8_agent(bf16* q, u32x2 w) { __hip_atomic_store((unsigned long long*)q, ((unsigned long long)w.y << 32) | w.x, __ATOMIC_RELAXED, __HIP_MEMORY_SCOPE_AGENT); }
template <bool WITH_Y, bool SAMPLE>
__device__ __forceinline__ void ssd_unit(const KP& p, LAS unsigned char* lds, int seq, int sc, int g, int tid, int wid, int lane, bool dry = false) {
    LAS bf16* XT = (LAS bf16*)lds;
    LAS bf16* BT = (LAS bf16*)(lds + 73728);
    LAS bf16* Cs = (LAS bf16*)(lds + 92160);
    LAS bf16* Bs = (LAS bf16*)(lds + 109568);
    LAS float* CBs = (LAS float*)(lds + 109568);
    LAS float* ACUM = (LAS float*)(lds + 126976);
    LAS float* DTL = ACUM + 512;
    LAS float* NP = DTL + 512;
    constexpr bool sample = SAMPLE; const int rowbase = sample ? MP + (seq - 2) * 64 : seq * 8192; constexpr int nch = sample ? 1 : 4; const int c0 = sc * 4;
    const int h = g * 8 + wid; const float a_h = -__expf(p.in[I_ALOG][h]); const float Dh = p.in[I_DSKIP][h];
    const int fr = lane & 15, q = lane >> 4;
    const bf16* XBC = (const bf16*)(p.ws + WS_XBC); const float* DT = (const float*)(p.ws + WS_DT);
    bf16* Zb = (bf16*)p.out; bf16* Sb = (bf16*)(p.ws + WS_S); float* CD = (float*)(p.ws + WS_CD);
    const float* cw = p.in[I_CONVW]; const float* cb = p.in[I_CONVB];
    u32x4 hs[4][4];
#pragma unroll
    for (int pb = 0; pb < 4; ++pb)
#pragma unroll
        for (int t = 0; t < 4; ++t) hs[pb][t] = (u32x4){0u, 0u, 0u, 0u};
    bf16* Sent = Sb + ((size_t)(seq * 32 + sc) * 32 + h) * 8192 + (size_t)fr * 128 + 4 * q;
    const float* Hin = p.in[I_STATE] + ((size_t)((sample ? seq - 2 : 0) * 32 + h) * 64 + fr) * 128 + 4 * q;
    float lastsum = 0.f;
#pragma unroll 1
    for (int cc = 0; cc < nch; ++cc) {
        const int cidx = c0 + cc; const int r0 = rowbase + cidx * 64;
        bf16* zrow = Zb + (size_t)(r0 + fr) * 2048 + h * 64 + 4 * q; bf16* sentc = Sent;
        asm volatile("" : "+v"(zrow), "+v"(sentc));
        const float dtv = DT[(size_t)(r0 + lane) * 32 + h];
        const int chl = wid * 64 + (lane & 7) * 8, j0 = (lane >> 3) * 8; int ch = g * 512 + chl;
        const int oct2 = tid & 31, seg2 = tid >> 5; const bool isC = oct2 >= 16; const bool bc_on = WITH_Y || !isC;
        const int nl = (oct2 & 15) * 8, j02 = seg2 * 4; int ch2 = 2048 + (isC ? 512 : 0) + g * 128 + nl;
        asm volatile("" : "+v"(ch), "+v"(ch2));
        u32x4 rawx[11], rawb[7];
#pragma unroll
        for (int r = 0; r < 11; ++r) rawx[r] = ssd_load8(p, XBC, seq, rowbase, cidx * 64 + j0 - 3 + r, ch);
        if (bc_on) {
#pragma unroll
            for (int r = 0; r < 7; ++r) rawb[r] = ssd_load8(p, XBC, seq, rowbase, cidx * 64 + j02 - 3 + r, ch2); }
        float acum = dtv * a_h;
#pragma unroll
        for (int o = 1; o < 64; o <<= 1) { const float t = __shfl_up(acum, o); if (lane >= o) acum += t; }
        const float last = __shfl(acum, 63);
        ACUM[wid * 64 + lane] = acum; DTL[wid * 64 + lane] = dtv;
        {
#pragma unroll
            for (int hf = 0; hf < 2; ++hf) {
                const int c4 = ch + 4 * hf;
                const f32x4 w0 = *(const f32x4*)(cw + c4), w1 = *(const f32x4*)(cw + 3072 + c4), w2 = *(const f32x4*)(cw + 6144 + c4), w3 = *(const f32x4*)(cw + 9216 + c4), bb = *(const f32x4*)(cb + c4);
                f32x4 x0, x1, x2, prev; unsigned pk[4][4];
#pragma unroll
                for (int r = 0; r < 11; ++r) {
                    const u32x4 rw = rawx[r];
                    const unsigned ra = hf ? rw.z : rw.x, rb = hf ? rw.w : rw.y; const f32x4 cur = (f32x4){bflo(ra), bfhi(ra), bflo(rb), bfhi(rb)};
                    if (r >= 3) { f32x4 t = bb + w0 * x0 + w1 * x1 + w2 * x2 + w3 * cur;
#pragma unroll
                        for (int e = 0; e < 4; ++e) t[e] = fsilu(t[e]);
                        if ((r - 3) & 1) {
#pragma unroll
                            for (int e = 0; e < 4; ++e) pk[e][(r - 3) >> 1] = cvt_pk_bf16(prev[e], t[e]); }
                        else prev = t; }
                    x0 = x1; x1 = x2; x2 = cur;
                }
#pragma unroll
                for (int e = 0; e < 4; ++e) *(LAS u32x4*)(XT + (size_t)(chl + 4 * hf + e) * 72 + j0) = (u32x4){pk[e][0], pk[e][1], pk[e][2], pk[e][3]};
                asm volatile("" ::: "memory");
            }
        }
        if (bc_on) {
#pragma unroll
            for (int hf = 0; hf < 2; ++hf) {
                const int c4 = ch2 + 4 * hf;
                const f32x4 w0 = *(const f32x4*)(cw + c4), w1 = *(const f32x4*)(cw + 3072 + c4), w2 = *(const f32x4*)(cw + 6144 + c4), w3 = *(const f32x4*)(cw + 9216 + c4), bb = *(const f32x4*)(cb + c4);
                f32x4 x0, x1, x2, o[4];
#pragma unroll
                for (int r = 0; r < 7; ++r) {
                    const unsigned ra = hf ? rawb[r].z : rawb[r].x, rb = hf ? rawb[r].w : rawb[r].y; const f32x4 cur = (f32x4){bflo(ra), bfhi(ra), bflo(rb), bfhi(rb)};
                    if (r >= 3) { f32x4 t = bb + w0 * x0 + w1 * x1 + w2 * x2 + w3 * cur;
#pragma unroll
                        for (int e = 0; e < 4; ++e) t[e] = fsilu(t[e]);
                        o[r - 3] = t; }
                    x0 = x1; x1 = x2; x2 = cur;
                }
                if (WITH_Y) {
#pragma unroll
                    for (int jj = 0; jj < 4; ++jj) *(LAS u32x2*)((isC ? Cs : Bs) + (j02 + jj) * 136 + nl + 4 * hf) = (u32x2){cvt_pk_bf16(o[jj][0], o[jj][1]), cvt_pk_bf16(o[jj][2], o[jj][3])};
                }
                if (!isC) {
#pragma unroll
                    for (int e = 0; e < 4; ++e) *(LAS u32x2*)(BT + (nl + 4 * hf + e) * 72 + j02) = (u32x2){cvt_pk_bf16(o[0][e], o[1][e]), cvt_pk_bf16(o[2][e], o[3][e])};
                }
                asm volatile("" ::: "memory");
            }
        }
        __syncthreads();
        LAS bf16* XTh = XT + wid * 64 * 72;
        if (WITH_Y) {
            const int ibc = wid >> 1, jb0 = (wid & 1) * 2; f32x4 cbt[2];
#pragma unroll
            for (int jt = 0; jt < 2; ++jt) { cbt[jt] = (f32x4){0.f, 0.f, 0.f, 0.f}; const int jb = jb0 + jt;
                if (jb <= ibc) {
#pragma unroll
                    for (int ks = 0; ks < 4; ++ks) { const bf16x8 X = *(const LAS bf16x8*)(Bs + (jb * 16 + fr) * 136 + ks * 32 + 8 * q), Y = *(const LAS bf16x8*)(Cs + (ibc * 16 + fr) * 136 + ks * 32 + 8 * q);
                        cbt[jt] = __builtin_amdgcn_mfma_f32_16x16x32_bf16(X, Y, cbt[jt], 0, 0, 0); } } }
            __syncthreads();
#pragma unroll
            for (int jt = 0; jt < 2; ++jt) *(LAS f32x4*)(CBs + (ibc * 16 + fr) * 68 + (jb0 + jt) * 16 + 4 * q) = cbt[jt];
            __syncthreads();
            f32x4 ya[4][4];
#pragma unroll
            for (int pb = 0; pb < 4; ++pb)
#pragma unroll
                for (int ib = 0; ib < 4; ++ib) ya[pb][ib] = (f32x4){0.f, 0.f, 0.f, 0.f};
#ifndef NO_YOFF
#pragma unroll
            for (int t = 0; t < 4; ++t) {
                u32x4 hf4[4];
#pragma unroll
                for (int pb = 0; pb < 4; ++pb) {
                    if (sample) { const f32x4 a = *(const f32x4*)(Hin + pb * 2048 + 32 * t), b = *(const f32x4*)(Hin + pb * 2048 + 32 * t + 16); hf4[pb] = (u32x4){cvt_pk_bf16(a[0], a[1]), cvt_pk_bf16(a[2], a[3]), cvt_pk_bf16(b[0], b[1]), cvt_pk_bf16(b[2], b[3])}; }
                    else { const u32x2 a = *(const u32x2*)(sentc + pb * 2048 + 32 * t), b = *(const u32x2*)(sentc + pb * 2048 + 32 * t + 16); hf4[pb] = (u32x4){a.x, a.y, b.x, b.y}; } }
#pragma unroll
                for (int ib = 0; ib < 4; ++ib) { const u32x2 ca = *(const LAS u32x2*)(Cs + (ib * 16 + fr) * 136 + 32 * t + 4 * q), cb2 = *(const LAS u32x2*)(Cs + (ib * 16 + fr) * 136 + 32 * t + 16 + 4 * q);
                    const bf16x8 Y = __builtin_bit_cast(bf16x8, ((u32x4){ca.x, ca.y, cb2.x, cb2.y}));
#pragma unroll
                    for (int pb = 0; pb < 4; ++pb) ya[pb][ib] = __builtin_amdgcn_mfma_f32_16x16x32_bf16(__builtin_bit_cast(bf16x8, hf4[pb]), Y, ya[pb][ib], 0, 0, 0); }
                asm volatile("" ::: "memory"); }
#pragma unroll
            for (int ib = 0; ib < 4; ++ib) { const float ea = __expf(ACUM[wid * 64 + ib * 16 + fr]);
#pragma unroll
                for (int pb = 0; pb < 4; ++pb) ya[pb][ib] = ya[pb][ib] * ea; }
#endif
            u32x2 zz[4][4];
#pragma unroll
            for (int ib = 0; ib < 4; ++ib)
#pragma unroll
                for (int pb = 0; pb < 4; ++pb) zz[ib][pb] = *(const u32x2*)(zrow + ib * 32768 + pb * 16);
#ifndef NO_YDIAG
#pragma unroll
            for (int ib = 0; ib < 4; ++ib)
#pragma unroll
                for (int ks = 0; ks < 2; ++ks) {
                    if (ks == 1 && ib < 2) continue;
                    const int i = ib * 16 + fr, js0 = ks * 32 + 8 * q; const float ai = ACUM[wid * 64 + i];
                    const f32x4 c0v = *(const LAS f32x4*)(CBs + i * 68 + js0), c1v = *(const LAS f32x4*)(CBs + i * 68 + js0 + 4);
                    const f32x4 a0 = *(const LAS f32x4*)(ACUM + wid * 64 + js0), a1 = *(const LAS f32x4*)(ACUM + wid * 64 + js0 + 4);
                    const f32x4 d0 = *(const LAS f32x4*)(DTL + wid * 64 + js0), d1 = *(const LAS f32x4*)(DTL + wid * 64 + js0 + 4);
                    float l[8];
#pragma unroll
                    for (int e = 0; e < 4; ++e) { l[e] = (js0 + e <= i) ? c0v[e] * __expf(ai - a0[e]) * d0[e] : 0.f; l[4 + e] = (js0 + 4 + e <= i) ? c1v[e] * __expf(ai - a1[e]) * d1[e] : 0.f; }
                    const bf16x8 Y = __builtin_bit_cast(bf16x8, pack8(l));
#pragma unroll
                    for (int pb = 0; pb < 4; ++pb) { const bf16x8 X = *(const LAS bf16x8*)(XTh + (pb * 16 + fr) * 72 + js0); ya[pb][ib] = __builtin_amdgcn_mfma_f32_16x16x32_bf16(X, Y, ya[pb][ib], 0, 0, 0); }
                    asm volatile("" ::: "memory");
                }
#endif
            float ss[4];
#pragma unroll
            for (int ib = 0; ib < 4; ++ib) { const int i = ib * 16 + fr; ss[ib] = 0.f;
#pragma unroll
                for (int pb = 0; pb < 4; ++pb) { const int pc = pb * 16 + 4 * q; const u32x2 z2 = zz[ib][pb];
                    const float zf[4] = {bflo(z2.x), bfhi(z2.x), bflo(z2.y), bfhi(z2.y)};
#pragma unroll
                    for (int jj = 0; jj < 4; ++jj) { const float xs = bf1(XTh[(pc + jj) * 72 + i]); const float gv = (ya[pb][ib][jj] + Dh * xs) * zf[jj]; ya[pb][ib][jj] = gv; ss[ib] += gv * gv; } }
                asm volatile("" ::: "memory");
                ss[ib] += __shfl_xor(ss[ib], 16); ss[ib] += __shfl_xor(ss[ib], 32);
                if (q == 0) NP[wid * 64 + i] = ss[ib]; }
            __syncthreads();
            f32x4 wv4[4];
#pragma unroll
            for (int pb = 0; pb < 4; ++pb) wv4[pb] = *(const f32x4*)(p.in[I_SNW] + h * 64 + pb * 16 + 4 * q);
#pragma unroll
            for (int ib = 0; ib < 4; ++ib) { const int i = ib * 16 + fr; float tot = 0.f;
#pragma unroll
                for (int w8 = 0; w8 < 8; ++w8) tot += NP[w8 * 64 + i];
                const float rstd = rsqrtf(tot * (1.f / 512.f) + EPS);
#pragma unroll
                for (int pb = 0; pb < 4; ++pb) { const int pc = pb * 16 + 4 * q; const f32x4 wv = wv4[pb];
                    float ov[4] = {ya[pb][ib][0] * rstd * wv[0], ya[pb][ib][1] * rstd * wv[1], ya[pb][ib][2] * rstd * wv[2], ya[pb][ib][3] * rstd * wv[3]};
#ifdef NAN_DBG
#pragma unroll
                    for (int e = 0; e < 4; ++e) ov[e] = (fabsf(ov[e]) < 1e30f) ? ov[e] : 0.f;
#endif
                    u32x2 o; o.x = cvt_pk_bf16(ov[0], ov[1]); o.y = cvt_pk_bf16(ov[2], ov[3]);
                    if (!dry) *(u32x2*)(zrow + ib * 32768 + pb * 16) = o; } }
        }
#ifndef NO_F
        if (!WITH_Y || sample || cc + 1 < nch) {
            const float e_last = __expf(last);
            bf16x8 Ys[4][2];
#pragma unroll
            for (int ks = 0; ks < 2; ++ks) { const int js0 = ks * 32 + 8 * q;
                const f32x4 a0 = *(const LAS f32x4*)(ACUM + wid * 64 + js0), a1 = *(const LAS f32x4*)(ACUM + wid * 64 + js0 + 4);
                const f32x4 d0 = *(const LAS f32x4*)(DTL + wid * 64 + js0), d1 = *(const LAS f32x4*)(DTL + wid * 64 + js0 + 4);
                float wj[8];
#pragma unroll
                for (int e = 0; e < 4; ++e) { wj[e] = d0[e] * __expf(last - a0[e]); wj[4 + e] = d1[e] * __expf(last - a1[e]); }
#pragma unroll
                for (int pb = 0; pb < 4; ++pb) { float x[8]; unpack8(*(const LAS u32x4*)(XTh + (pb * 16 + fr) * 72 + js0), x);
#pragma unroll
                    for (int e = 0; e < 8; ++e) x[e] *= wj[e];
                    Ys[pb][ks] = __builtin_bit_cast(bf16x8, pack8(x)); } }
#pragma unroll
            for (int t = 0; t < 4; ++t) {
                u32x2 oldp[2][4]; f32x4 olds[2][4];
#pragma unroll
                for (int hf = 0; hf < 2; ++hf)
#pragma unroll
                    for (int pb = 0; pb < 4; ++pb) {
                        if (sample) olds[hf][pb] = *(const f32x4*)(Hin + pb * 2048 + (2 * t + hf) * 16);
                        else if (WITH_Y) oldp[hf][pb] = *(const u32x2*)(sentc + pb * 2048 + (2 * t + hf) * 16); }
#pragma unroll
                for (int hf = 0; hf < 2; ++hf) { const int nb = 2 * t + hf;
                    const bf16x8 X0 = *(const LAS bf16x8*)(BT + (nb * 16 + fr) * 72 + 8 * q), X1 = *(const LAS bf16x8*)(BT + (nb * 16 + fr) * 72 + 32 + 8 * q);
#pragma unroll
                    for (int pb = 0; pb < 4; ++pb) {
                        f32x4 a;
                        if (sample) { a = olds[hf][pb] * e_last; }
                        else if (WITH_Y) { const u32x2 w = oldp[hf][pb]; a = (f32x4){bflo(w.x), bfhi(w.x), bflo(w.y), bfhi(w.y)} * e_last; }
                        else { const unsigned w0 = hf ? hs[pb][t].z : hs[pb][t].x, w1 = hf ? hs[pb][t].w : hs[pb][t].y; a = (f32x4){bflo(w0), bfhi(w0), bflo(w1), bfhi(w1)} * e_last; }
                        a = __builtin_amdgcn_mfma_f32_16x16x32_bf16(X0, Ys[pb][0], a, 0, 0, 0);
                        a = __builtin_amdgcn_mfma_f32_16x16x32_bf16(X1, Ys[pb][1], a, 0, 0, 0);
                        if (sample) { if (!dry) __builtin_nontemporal_store(a, (f32x4*)(p.out + O_SS + (((size_t)(seq - 2) * 32 + h) * 64 + pb * 16 + fr) * 128 + nb * 16 + 4 * q)); }
                        else if (WITH_Y) { if (!dry) *(u32x2*)(sentc + pb * 2048 + nb * 16) = (u32x2){cvt_pk_bf16(a[0], a[1]), cvt_pk_bf16(a[2], a[3])}; }
                        else { const unsigned w0 = cvt_pk_bf16(a[0], a[1]), w1 = cvt_pk_bf16(a[2], a[3]); if (hf) { hs[pb][t].z = w0; hs[pb][t].w = w1; } else { hs[pb][t].x = w0; hs[pb][t].y = w1; } }
                    } }
                asm volatile("" ::: "memory"); }
        }
#endif
        lastsum += last;
        __syncthreads();
    }
    if (!WITH_Y) {
#pragma unroll
        for (int pb = 0; pb < 4; ++pb)
#pragma unroll
            for (int t = 0; t < 4; ++t) { bf16* s0 = Sb + (((size_t)(seq * 32 + sc) * 32 + h) * 64 + pb * 16 + fr) * 128 + 32 * t + 4 * q;
                *(u32x2*)s0 = (u32x2){hs[pb][t].x, hs[pb][t].y}; *(u32x2*)(s0 + 16) = (u32x2){hs[pb][t].z, hs[pb][t].w}; }
        if (lane == 0) CD[(seq * 32 + sc) * 32 + h] = lastsum;
    }
}

__device__ __forceinline__ void phase_scan(const KP& p, int tid, bool dry = false) {
    asm volatile("" : "+v"(tid));
    const int gid = blockIdx.x * NT + tid;
    if (gid >= 131072) return;
    const int seq = gid >> 16, rem = gid & 65535, h = rem >> 11;
    bf16* Sb = (bf16*)(p.ws + WS_S); const float* CD = (const float*)(p.ws + WS_CD);
    f32x4 hv = (f32x4){0.f, 0.f, 0.f, 0.f};
    u32x2 sv[32]; float ev[32];
#pragma unroll
    for (int sc = 0; sc < 32; ++sc) { sv[sc] = *(const u32x2*)(Sb + (size_t)(seq * 32 + sc) * 262144 + (size_t)rem * 4); ev[sc] = CD[(seq * 32 + sc) * 32 + h]; }
#pragma unroll
    for (int sc = 0; sc < 32; ++sc) {
        u32x2* sp = (u32x2*)(Sb + (size_t)(seq * 32 + sc) * 262144 + (size_t)rem * 4);
        const u32x2 s = sv[sc]; const float e = __expf(ev[sc]);
        if (!dry) *sp = (u32x2){cvt_pk_bf16(hv[0], hv[1]), cvt_pk_bf16(hv[2], hv[3])};
        hv = hv * e + (f32x4){bflo(s.x), bfhi(s.x), bflo(s.y), bfhi(s.y)};
    }
    if (!dry) *(f32x4*)(p.out + O_SP + (size_t)seq * 262144 + (size_t)rem * 4) = hv;
}

__device__ __forceinline__ float load_row_sq(f32x4 (&t)[4], const bf16* O, const float* ST, const float* SL, int ns, int m, int lane) {
    float s = 0.f;
    if (m < MP) { const u32x2* r = (const u32x2*)(O + (size_t)m * D) + lane;
#pragma unroll
        for (int j = 0; j < 4; ++j) { const u32x2 w = r[64 * j]; t[j] = (f32x4){bflo(w.x), bfhi(w.x), bflo(w.y), bfhi(w.y)}; }
        s = lane < 16 ? ST[(size_t)m * 16 + lane] : 0.f;
    } else {
#pragma unroll
        for (int j = 0; j < 4; ++j) t[j] = (f32x4){0.f, 0.f, 0.f, 0.f};
        for (int k = 0; k < ns; ++k) { const f32x4* r = (const f32x4*)(SL + ((size_t)k * MS + (m - MP)) * D) + lane;
#pragma unroll
            for (int j = 0; j < 4; ++j) t[j] = t[j] + r[64 * j]; }
#pragma unroll
        for (int j = 0; j < 4; ++j) s += (t[j][0] * t[j][0] + t[j][1] * t[j][1]) + (t[j][2] * t[j][2] + t[j][3] * t[j][3]);
    }
    return wave_sum(s);
}
__device__ __forceinline__ void phase_mgs(const KP& p, int wid, int lane) {
    asm volatile("" : "+v"(lane));
    const int gw = blockIdx.x * 8 + wid, NGW = gridDim.x * 8;
    const float* SLA = (const float*)(p.ws + WS_SLA); const float* SLB = (const float*)(p.ws + WS_SLB); const bf16* GS = (const bf16*)(p.ws + WS_GABS); bf16* MG = (bf16*)(p.ws + WS_T);
    for (int m = gw; m < MS; m += NGW) {
#pragma unroll
        for (int j = 0; j < 4; ++j) { const int col = 4 * lane + 256 * j;
            f32x4 pa = *(const f32x4*)(SLA + (size_t)m * D + col) + *(const f32x4*)(SLA + ((size_t)MS + m) * D + col);
            f32x4 pb = (*(const f32x4*)(SLB + (size_t)m * D + col) + *(const f32x4*)(SLB + ((size_t)MS + m) * D + col)) + (*(const f32x4*)(SLB + ((size_t)2 * MS + m) * D + col) + *(const f32x4*)(SLB + ((size_t)3 * MS + m) * D + col));
            const u32x2 a = *(const u32x2*)(GS + (size_t)m * 2048 + col), b = *(const u32x2*)(GS + (size_t)m * 2048 + 1024 + col);
            const f32x4 sa = (f32x4){bflo(a.x), bfhi(a.x), bflo(a.y), bfhi(a.y)}, sb = (f32x4){bflo(b.x), bfhi(b.x), bflo(b.y), bfhi(b.y)};
            const f32x4 o = sa * pa + sb * pb;
            *(u32x2*)(MG + (size_t)(MP + m) * D + col) = (u32x2){cvt_pk_bf16(o[0], o[1]), cvt_pk_bf16(o[2], o[3])}; }
    }
}
__device__ __forceinline__ void phase_x1(const KP& p, int wid, int lane) {
    asm volatile("" : "+v"(lane));
    const int gw = blockIdx.x * 8 + wid, NGW = gridDim.x * 8;
    bf16* X1N = (bf16*)(p.ws + WS_X1N);
    for (int m = gw; m < M; m += NGW) {
        f32x4 t[4]; const float rstd = rsqrtf(load_row_sq(t, (const bf16*)(p.ws + WS_T2), (const float*)(p.ws + WS_ST), (const float*)(p.ws + WS_ACO), 4, m, lane) * (1.f / D) + EPS);
        const f32x4* xr = (const f32x4*)xrow(p, m) + lane; const f32x4* wr4 = (const f32x4*)p.in[I_POSTMIX] + lane;
        f32x4 v[4]; float s2 = 0.f;
#pragma unroll
        for (int j = 0; j < 4; ++j) { v[j] = __builtin_nontemporal_load(xr + 64 * j) + t[j] * rstd * wr4[64 * j]; s2 += (v[j][0] * v[j][0] + v[j][1] * v[j][1]) + (v[j][2] * v[j][2] + v[j][3] * v[j][3]); }
        const float r2 = rsqrtf(wave_sum(s2) * (1.f / D) + EPS);
        f32x4* o = (f32x4*)(p.out + (size_t)m * D) + lane; u32x2* o2 = (u32x2*)(X1N + (size_t)m * D) + lane;
#pragma unroll
        for (int j = 0; j < 4; ++j) { __builtin_nontemporal_store(v[j], o + 64 * j); u32x2 w; w.x = cvt_pk_bf16(v[j][0] * r2, v[j][1] * r2); w.y = cvt_pk_bf16(v[j][2] * r2, v[j][3] * r2); o2[64 * j] = w; }
    }
}
__device__ __forceinline__ void phase_final(const KP& p, int wid, int lane) {
    asm volatile("" : "+v"(lane));
    const int gw = blockIdx.x * 8 + wid, NGW = gridDim.x * 8;
    for (int m = gw; m < M; m += NGW) {
        f32x4 t[4]; const float rstd = rsqrtf(load_row_sq(t, (const bf16*)(p.ws + WS_F), (const float*)(p.ws + WS_ST2), (const float*)(p.ws + WS_ACF), 8, m, lane) * (1.f / D) + EPS);
        f32x4* o = (f32x4*)(p.out + (size_t)m * D) + lane; const f32x4* wr4 = (const f32x4*)p.in[I_POSTFFN] + lane;
#pragma unroll
        for (int j = 0; j < 4; ++j) __builtin_nontemporal_store(__builtin_nontemporal_load(o + 64 * j) + t[j] * rstd * wr4[64 * j], o + 64 * j);
    }
}
__device__ __forceinline__ void zero_f32(float* q, int n4, int tid) {
    asm volatile("" : "+v"(tid));
    for (int i = blockIdx.x * NT + tid; i < n4; i += gridDim.x * NT) ((f32x4*)q)[i] = (f32x4){0.f, 0.f, 0.f, 0.f};
}

#define XB_TMO      128
#define XB_XCNT(j)  (256  + 64 * (j))
#define XB_XSUB(j)  (1280 + 64 * (j))
#define XB_XGEN(j)  (2304 + 64 * (j))
#define XB_TOP      3328
#define XB_TOPGEN   3392
#define XCD_BAR_WORDS 3456
#define XB_SPIN_CAP (1u << 18)

__device__ __forceinline__ unsigned xb_ld(unsigned* p)              { return __hip_atomic_load(p, __ATOMIC_RELAXED, __HIP_MEMORY_SCOPE_AGENT); }
__device__ __forceinline__ unsigned xb_add(unsigned* p, unsigned v) { return __hip_atomic_fetch_add(p, v, __ATOMIC_RELAXED, __HIP_MEMORY_SCOPE_AGENT); }
__device__ __forceinline__ unsigned xb_xcc_id() { return (unsigned)__builtin_amdgcn_s_getreg((3 << 11) | 20) & 0xFu; }
#define XB_SPIN(cond, bar) do { unsigned _sp = 0; while (cond) { __builtin_amdgcn_s_sleep(1); \
    if ((++_sp & 255u) == 0u) { if (xb_ld(&(bar)[XB_TMO])) break; if (_sp > XB_SPIN_CAP) { atomicAdd(&(bar)[XB_TMO], 1u); break; } } } } while (0)

struct XcdBarrier {
    unsigned* bar; unsigned x;
    volatile LAS unsigned* st;
};

__device__ __forceinline__ XcdBarrier xcd_barrier_post(unsigned* bar, volatile LAS unsigned* st) {
    XcdBarrier b; b.bar = bar; b.x = xb_xcc_id(); b.st = st;
    if (threadIdx.x == 0) (void)xb_add(&bar[XB_XCNT(b.x)], 1u);
    return b;
}
__device__ __forceinline__ void xcd_barrier_complete(unsigned* bar, unsigned x, unsigned& nloc, unsigned& nx) {
    const unsigned G = gridDim.x * gridDim.y * gridDim.z;
    unsigned sum, cnt, mine, sp = 0u;
    for (;;) {
        sum = 0u; cnt = 0u; mine = 0u;
#pragma unroll
        for (unsigned j = 0; j < 16; ++j) { const unsigned c = xb_ld(&bar[XB_XCNT(j)]); sum += c; cnt += (c > 0u) ? 1u : 0u; mine = (j == x) ? c : mine; }
        if (sum == G) break;
        __builtin_amdgcn_s_sleep(1);
        if ((++sp & 255u) == 0u) { if (xb_ld(&bar[XB_TMO])) break; if (sp > XB_SPIN_CAP) { atomicAdd(&bar[XB_TMO], 1u); break; } }
    }
    nloc = mine > 0u ? mine : 1u; nx = cnt > 0u ? cnt : 1u;
}

__device__ __forceinline__ void xcd_barrier(const XcdBarrier& b) {
    asm volatile("s_waitcnt vmcnt(0)" ::: "memory");
    __syncthreads();
    if (threadIdx.x == 0) {
        unsigned* bar = b.bar;
        __builtin_amdgcn_s_waitcnt(0);
        unsigned nloc = b.st[0], nx = b.st[1];
        if (nloc == 0u) { xcd_barrier_complete(bar, b.x, nloc, nx); b.st[0] = nloc; b.st[1] = nx; }
        const unsigned old = xb_add(&bar[XB_XSUB(b.x)], 1u);
        const unsigned gen = old / nloc;
        if (old + 1u == (gen + 1u) * nloc) {
            __builtin_amdgcn_fence(__ATOMIC_RELEASE, "agent");
            asm volatile("s_waitcnt vmcnt(0)" ::: "memory");
            const unsigned og = xb_add(&bar[XB_TOP], 1u);
            const unsigned tg = og / nx;
            if (og + 1u == (tg + 1u) * nx) xb_add(&bar[XB_TOPGEN], 1u);
            else XB_SPIN(xb_ld(&bar[XB_TOPGEN]) == tg, bar);
            __builtin_amdgcn_fence(__ATOMIC_ACQUIRE, "agent");
            xb_add(&bar[XB_XGEN(b.x)], 1u);
            asm volatile("s_waitcnt vmcnt(0)" ::: "memory");
        } else {
            XB_SPIN(xb_ld(&bar[XB_XGEN(b.x)]) == gen, bar);
            __builtin_amdgcn_fence(__ATOMIC_ACQUIRE, "agent");
            asm volatile("s_waitcnt vmcnt(0)" ::: "memory");
        }
    }
    __syncthreads();
}

constexpr int NPHASE = 14;
__global__ void __launch_bounds__(NT, 2) hybrid_fwd(KP p) {
#define RELOAD_P() do { } while (0)
    extern __shared__ __attribute__((aligned(16))) unsigned char lds_raw[];
    LAS unsigned char* lds = (LAS unsigned char*)lds_raw;
    const int tid = threadIdx.x, lane = tid & 63, wid = __builtin_amdgcn_readfirstlane(tid >> 6);
    const int G = gridDim.x, c = blockIdx.x;
    unsigned char* ws = p.ws;
    const int lo = p.ph_lo, hi = p.ph_hi;
#ifndef PHMASK
#define PHMASK 0x7fff
#endif
#if MK_LAUNCHES == 1
#define IN(k) (((PHMASK >> (k)) & 1) != 0)
#else
#define IN(k) (((PHMASK >> (k)) & 1) && lo <= (k) && (k) < hi)
#endif
#ifndef DUPMASK
#define DUPMASK 0
#endif
#define REP(k) for (int rep_ = 0; rep_ < (((DUPMASK >> (k)) & 1) ? 2 : 1); ++rep_)
#if MK_LAUNCHES == 1
#define SEAM(k) do { if (IN(k) && IN((k) + 1)) xcd_barrier(xbar); } while (0)
#else
#define SEAM(k) do { } while (0)
#endif
    volatile LAS unsigned* xst = (volatile LAS unsigned*)(lds + LDS_BYTES - 64);
    if (tid < 2) xst[tid] = 0u;
    __syncthreads();
    XcdBarrier xbar; xbar.bar = (unsigned*)ws; xbar.x = 0; xbar.st = xst;
#if MK_LAUNCHES == 1
    xbar = xcd_barrier_post((unsigned*)ws, xst);
#endif
    if (hi < 0) cg::this_grid().sync();
    bf16* Win = (bf16*)(ws + WS_WIN);
    RELOAD_P();
    if (IN(0)) phase_prologue(p, lds, wid, lane, 0);
    SEAM(0);
    RELOAD_P();
    if (IN(1)) {
        pg8::Gemm g{(const bf16*)(ws + WS_XN), Win, M, 7424, D}; pg8::InOrder S; S.init(M, 7424, G, c);
        EpiIn E{EpiUV{(bf16*)(ws + WS_U), (bf16*)(ws + WS_G), (f32x2v*)(ws + WS_VST)}, EpiZXD{(bf16*)p.out, (bf16*)(ws + WS_XBC), (float*)(ws + WS_DT), p.in[I_DTB], p.out}, EpiG{(bf16*)(ws + WS_GABS), MP}};
        pg8::gemm_phase<EpiIn, pg8::InOrder, true, true>(lds, g, S, E);
    }
    SEAM(1);
    RELOAD_P();
    if (IN(2)) {
        if (c < 64) { ssd_unit<true, true>(p, lds, 2 + (c >> 2), 0, c & 3, tid, wid, lane);
            for (int u = c; u < 128; u += 64) gmlp_unit(p, lds, u >> 3, u & 7, tid, wid, lane); }
        else { for (int u = 128 + (c - 64); u < 144 * 8; u += G - 64) gmlp_unit(p, lds, u >> 3, u & 7, tid, wid, lane);
            phase_prologue(p, lds, wid, lane, 1, (c - 64) * 8 + wid, (G - 64) * 8); }
    }
    SEAM(2);
    RELOAD_P();
    if (IN(3)) { for (int u = c; u < 256; u += G) ssd_unit<false, false>(p, lds, u >> 7, (u >> 2) & 31, u & 3, tid, wid, lane); }
    SEAM(3);
    RELOAD_P();
    if (IN(4)) phase_scan(p, tid);
    SEAM(4);
    RELOAD_P();
    if (IN(5)) { for (int u = c; u < 256; u += G) ssd_unit<true, false>(p, lds, u >> 7, (u >> 2) & 31, u & 3, tid, wid, lane); }
    SEAM(5);
#pragma clang loop unroll(disable)
    for (int ph = 6; ph <= 13; ++ph) {
        RELOAD_P();
        if (IN(ph)) {
            if (ph == 9) phase_mgs(p, wid, lane);
            else if (ph == 11) phase_x1(p, wid, lane);
            else if (ph == 12) {
                pg8::Gemm g{(const bf16*)(ws + WS_X1N), (const bf16*)(ws + WS_WUP), M, FF, D}; pg8::StaticOrder S; S.init(M, FF, G, c);
                EpiUp E{(bf16*)(ws + WS_H)};
                pg8::gemm_phase<EpiUp, pg8::StaticOrder, true, true>(lds, g, S, E);
            } else {
                const bf16* A; const bf16* B; int K, log_ns, nk, gate = 0; EpiGen E; E.GAB = (const bf16*)(ws + WS_GAB); E.T = (const bf16*)(ws + WS_T); E.ST = (float*)(ws + WS_ST);
                if (ph == 6)       { A = (const bf16*)(ws + WS_XN); B = Win + (size_t)7424 * D;     K = D;    log_ns = 0; nk = 0; E.mode = 3; E.O = (bf16*)(ws + WS_GAB); E.SL = nullptr; E.kb_shift = 0; gate = 1; }
                else if (ph == 7)  { A = (const bf16*)(ws + WS_U);  B = (const bf16*)(ws + WS_WA);  K = D;    log_ns = 1; nk = 8; E.mode = 0; E.O = (bf16*)(ws + WS_T);  E.SL = (float*)(ws + WS_SLA); E.kb_shift = 10; }
                else if (ph == 8)  { A = (const bf16*)p.out;        B = (const bf16*)(ws + WS_WB);  K = 2048; log_ns = 2; nk = 8; E.mode = 1; E.O = (bf16*)(ws + WS_T);  E.SL = (float*)(ws + WS_SLB); E.kb_shift = 10; }
                else if (ph == 10) { A = (const bf16*)(ws + WS_T);  B = (const bf16*)(ws + WS_WO);  K = D;    log_ns = 2; nk = 4; E.mode = 2; E.O = (bf16*)(ws + WS_T2); E.SL = (float*)(ws + WS_ACO); E.kb_shift = 9; }
                else               { A = (const bf16*)(ws + WS_H);  B = (const bf16*)(ws + WS_WDN); K = FF;   log_ns = 3; nk = 8; E.mode = 2; E.O = (bf16*)(ws + WS_F);  E.SL = (float*)(ws + WS_ACF); E.kb_shift = 10; }
                pg8::Gemm g{A, B, M, D, K}; pg8::TailOrder S; S.init(log_ns, nk, G, c, gate, ph == 8 ? 32 : 0);
                pg8::gemm_phase<EpiGen, pg8::TailOrder, true, true>(lds, g, S, E);
            }
        }
        if (ph == 6 || ph == 7) __syncthreads();
        else if (IN(ph) && IN(ph + 1)) xcd_barrier(xbar);
    }
    RELOAD_P();
    if (IN(14)) phase_final(p, wid, lane);
#undef IN
#undef SEAM
#undef RELOAD_P
}

extern "C" void kernel_launch(void* const* d_in, const int* in_sizes, int n_in, void* d_out, int out_size, void* d_ws, size_t ws_size, hipStream_t stream) {
    static int grid = 0;
    if (grid == 0) {
        if (n_in != 24 || ws_size < WS_END) { fprintf(stderr, "kernel_launch: unexpected n_in %d / ws_size %zu\n", n_in, ws_size); grid = -1; return; }
        int dev = 0, cus = 0, per_cu = 0;
        hipGetDevice(&dev); hipDeviceGetAttribute(&cus, hipDeviceAttributeMultiprocessorCount, dev);
        hipFuncSetAttribute((const void*)hybrid_fwd, hipFuncAttributeMaxDynamicSharedMemorySize, LDS_BYTES);
        hipOccupancyMaxActiveBlocksPerMultiprocessor(&per_cu, (const void*)hybrid_fwd, NT, LDS_BYTES);
        (void)hipGetLastError();
        if (per_cu < 1) fprintf(stderr, "kernel_launch: occupancy query says %d blocks/CU\n", per_cu);
        grid = cus;
    }
    if (grid < 0) return;
    KP a{};
    for (int i = 0; i < 24; ++i) a.in[i] = (const float*)d_in[i];
    a.out = (float*)d_out; a.ws = (unsigned char*)d_ws;
#if MK_LAUNCHES == 1
    (void)hipMemsetAsync(d_ws, 0, 16384, stream);
    a.ph_lo = 0; a.ph_hi = NPHASE + 1;
    void* args[] = {&a};
    hipError_t e = hipLaunchCooperativeKernel((const void*)hybrid_fwd, dim3(grid), dim3(NT), args, LDS_BYTES, stream);
    if (e != hipSuccess) fprintf(stderr, "cooperative launch failed: %s (grid %d)\n", hipGetErrorString(e), grid);
#else
#ifndef LASTPH
#define LASTPH NPHASE
#endif
    for (int k = 0; k <= LASTPH; ++k) { a.ph_lo = k; a.ph_hi = k + 1; hipLaunchKernelGGL(hybrid_fwd, dim3(grid), dim3(NT), LDS_BYTES, stream, a); }
#endif
}
```

```cpp
#include <hip/hip_runtime.h>
#include <hip/hip_cooperative_groups.h>
#include <cstdio>
#include <cstdint>
namespace cg = cooperative_groups;
namespace pg8 {
#define PG8_LAS __attribute__((address_space(3)))
typedef unsigned short bf16_t;
typedef short bf16x8 __attribute__((ext_vector_type(8)));
typedef float f32x4 __attribute__((ext_vector_type(4)));
typedef unsigned u32x4 __attribute__((ext_vector_type(4)));
constexpr int BM = 256, BK = 64, HALF = 128, HTB = HALF * BK * 2  , STAGE_BYTES = 8 * HTB, NXCD = 8, WGM = 8;

__host__ __device__ __forceinline__ int lds_byte(int r, int c) { const int st = (r >> 4) * 2 + (c >> 5), rr = r & 15, cc = c & 31, ob = rr * 64 + cc * 2; return st * 1024 + (ob ^ (((ob >> 9) & 1) << 5)); }
__host__ __device__ __forceinline__ void stage_rc(int b, int& R, int& C) { const int st = b / 1024, sb = b % 1024, swz = sb ^ (((sb >> 9) & 1) << 5); R = (st >> 1) * 16 + swz / 64; C = (st & 1) * 32 + (swz % 64) / 2; }
__host__ __device__ __forceinline__ int perm32(int rho) { const int n = rho >> 4, i = rho & 15; return 8 * (i >> 2) + 4 * n + (i & 3); }

struct Unit { int pm, pn, kb, nk; };
struct Gemm { const bf16_t* A; const bf16_t* Bt; int M, N, K; };

struct StaticOrder {
    int nM, nN, nwg, G, c;
    __host__ __device__ void init(int M, int N, int G_, int c_) { nM = M / BM; nN = N / BM; nwg = nM * nN; G = G_; c = c_; }
    __host__ __device__ bool next(int i, Unit& u) const {
        const long L = (long)i * G + c; if (L >= nwg) return false;
        int wgid = (int)L; { const int q = nwg / NXCD, r = nwg % NXCD, xcd = wgid % NXCD, off = wgid / NXCD; wgid = (xcd < r ? xcd * (q + 1) : r * (q + 1) + (xcd - r) * q) + off; }
        const int nig = WGM * nN, gid = wgid / nig, fm = gid * WGM, gsz = (nM - fm) < WGM ? (nM - fm) : WGM;
        u.pm = fm + ((wgid % nig) % gsz); u.pn = (wgid % nig) / gsz; u.kb = 0; u.nk = 0; return true;
    }
    __device__ __forceinline__ void a_ready(const Unit&) const {}
    __device__ __forceinline__ void done(const Unit&) const {}
};
struct InOrder {
    StaticOrder so; int np, G, cx;
    __host__ __device__ void init(int M, int N, int G_, int c_) { so.init(M, N, G_, c_); np = c_ < so.nwg ? (so.nwg - c_ + G_ - 1) / G_ : 0; G = G_; cx = (c_ - (so.nwg % G_) + G_) % G_; }
    __host__ __device__ bool next(int i, Unit& u) const {
        if (i < np) return so.next(i, u);
        const int l = (i - np) * G + cx; if (l >= 32) return false;
        u.pm = 64 + (l >> 3); u.pn = 29 + (l & 7); u.kb = 0; u.nk = 0; return true;
    }
    __device__ __forceinline__ void a_ready(const Unit&) const {}
    __device__ __forceinline__ void done(const Unit&) const {}
};
struct TailOrder {
    StaticOrder so; int np, n, G, c, log_ns, nk, gate, cx;
    __host__ __device__ void init(int log_ns_, int nk_, int G_, int c_, int gate_ = 0, int coff = 0) { cx = (c_ - coff % G_ + G_) % G_; so.init(64 * BM, 4 * BM, G_, c_); np = c_ < so.nwg ? (so.nwg - c_ + G_ - 1) / G_ : 0; log_ns = log_ns_; nk = nk_; n = gate_ ? 0 : (16 << log_ns_); G = G_; c = c_; gate = gate_; if (gate_) np *= 2; }
    __host__ __device__ bool next(int i, Unit& u) const {
        if (i < np) { if (!gate) return so.next(i, u); const bool ok = so.next(i >> 1, u); u.pn += 4 * (i & 1); return ok; }
        const int l = (i - np) * G + cx; if (l >= n) return false;
        u.kb = (l & ((1 << log_ns) - 1)) * (nk * BK * 2); u.nk = nk; const int t = l >> log_ns; u.pn = t & 3; u.pm = 64 + (t >> 2); return true;
    }
    __device__ __forceinline__ void a_ready(const Unit&) const {}
    __device__ __forceinline__ void done(const Unit&) const {}
};

__device__ __forceinline__ unsigned cvt_pk_bf16(float lo, float hi) { unsigned r; asm volatile("v_cvt_pk_bf16_f32 %0, %1, %2" : "=v"(r) : "v"(lo), "v"(hi)); return r; }
typedef float f32x2 __attribute__((ext_vector_type(2)));
template <class Epi, class Sched, bool ALIGN_EPI = false, bool SP2 = false>
__device__ __forceinline__ void gemm_phase(PG8_LAS unsigned char* lds, const Gemm g, const Sched& S, const Epi& E) {
    int tid_ = threadIdx.x; asm volatile("" : "+v"(tid_));
    const int tid = tid_, wid = __builtin_amdgcn_readfirstlane(tid >> 6), lane = tid & 63, wr = wid >> 2, wc = wid & 3, fr = lane & 15, fq = lane >> 4;
    const int K = g.K, ntfull = K / BK;
    unsigned voffA[2], voffB[2];
#pragma unroll
    for (int i = 0; i < 2; ++i) { int R, C; stage_rc(tid * 16 + i * 8192, R, C); const int Rb = Epi::PERM ? ((R & ~31) + perm32(R & 31)) : R;
        voffA[i] = (unsigned)(R * K + C) * 2u; voffB[i] = (unsigned)(Rb * K + C) * 2u; }
    const size_t kstep = (size_t)(BK * 2);
    const size_t hstep = (size_t)HALF * K * 2;
    const size_t tstep = 2 * hstep;
    const unsigned ldsw = (unsigned)wid * 1024u;
    const int aoff = lds_byte(wr * 64 + fr, fq * 8), boff = lds_byte(wc * 32 + fr, fq * 8);
#define PG8_SA(b, h) (((b) * 2 + (h)) * HTB)
#define PG8_SB(b, h) ((4 + (b) * 2 + (h)) * HTB)
#define PG8_STAGE(bufoff, gbase, voff) do { _Pragma("unroll") for (int _i = 0; _i < 2; ++_i) \
        __builtin_amdgcn_global_load_lds((const unsigned*)((const char*)(gbase) + (voff)[_i]), (PG8_LAS unsigned*)(lds + (bufoff) + ldsw + _i * 8192), 16, 0, 0); } while (0)
#define PG8_LDA(dst, b, h) do { _Pragma("unroll") for (int m = 0; m < 4; ++m) _Pragma("unroll") for (int k = 0; k < 2; ++k) dst[m][k] = *(const PG8_LAS bf16x8*)(lds + PG8_SA(b, h) + aoff + m * 2048 + k * 1024); } while (0)
#define PG8_LDB(dst, b, h) do { _Pragma("unroll") for (int n = 0; n < 2; ++n) _Pragma("unroll") for (int k = 0; k < 2; ++k) dst[n][k] = *(const PG8_LAS bf16x8*)(lds + PG8_SB(b, h) + boff + n * 2048 + k * 1024); } while (0)
#define PG8_MMA(ai, bj, At, Bt) do { __builtin_amdgcn_s_setprio(1); _Pragma("unroll") for (int m = 0; m < 4; ++m) _Pragma("unroll") for (int n = 0; n < 2; ++n) _Pragma("unroll") for (int k = 0; k < 2; ++k) \
        acc[ai][bj][m][n] = __builtin_amdgcn_mfma_f32_16x16x32_bf16(Bt[n][k], At[m][k], acc[ai][bj][m][n], 0, 0, 0); __builtin_amdgcn_s_setprio(0); } while (0)
#define PG8_WAIT_V(n) asm volatile("s_waitcnt vmcnt(" #n ")" ::: "memory")
#define PG8_WAIT_L(n) asm volatile("s_waitcnt lgkmcnt(" #n ")" ::: "memory")
#define PG8_BAR __builtin_amdgcn_s_barrier()
#define PG8_SCHED __builtin_amdgcn_sched_barrier(0)
    Unit cur, nxt; int ui = 0;
    if (!S.next(0, cur)) return;
    f32x4 acc[2][2][4][2];
#pragma unroll
    for (int a = 0; a < 2; ++a)
#pragma unroll
        for (int b = 0; b < 2; ++b)
#pragma unroll
            for (int m = 0; m < 4; ++m)
#pragma unroll
                for (int n = 0; n < 2; ++n) acc[a][b][m][n] = (f32x4){0.f, 0.f, 0.f, 0.f};
    bf16x8 At[4][2], B0[2][2], B1[2][2];
    const char* cA = (const char*)g.A + (size_t)cur.pm * tstep + cur.kb; const char* cB = (const char*)g.Bt + (size_t)cur.pn * tstep + cur.kb;
    S.a_ready(cur);
    if constexpr (SP2) {
        PG8_STAGE(PG8_SB(0, 0), cB, voffB); PG8_STAGE(PG8_SB(0, 1), cB + hstep, voffB); PG8_STAGE(PG8_SA(0, 0), cA, voffA); PG8_STAGE(PG8_SA(0, 1), cA + hstep, voffA);
        if (wr == 1) PG8_BAR;
        PG8_WAIT_V(2); PG8_BAR;
        PG8_STAGE(PG8_SB(1, 0), cB + kstep, voffB); PG8_STAGE(PG8_SA(1, 0), cA + kstep, voffA); PG8_STAGE(PG8_SB(1, 1), cB + hstep + kstep, voffB);
        PG8_WAIT_V(6); PG8_BAR;
    } else {
        PG8_STAGE(PG8_SB(0, 0), cB, voffB); PG8_STAGE(PG8_SA(0, 0), cA, voffA); PG8_STAGE(PG8_SB(0, 1), cB + hstep, voffB); PG8_STAGE(PG8_SA(0, 1), cA + hstep, voffA);
        if (wr == 1) PG8_BAR;
        PG8_WAIT_V(4); PG8_BAR;
        PG8_STAGE(PG8_SB(1, 0), cB + kstep, voffB); PG8_STAGE(PG8_SA(1, 0), cA + kstep, voffA); PG8_STAGE(PG8_SB(1, 1), cB + hstep + kstep, voffB);
        PG8_WAIT_V(6); PG8_BAR;
    }
    for (;;) {
        const bool has_next = S.next(ui + 1, nxt);
        const char* nA = has_next ? (const char*)g.A + (size_t)nxt.pm * tstep + nxt.kb : cA; const char* nB = has_next ? (const char*)g.Bt + (size_t)nxt.pn * tstep + nxt.kb : cB;
        const int nt = cur.nk ? cur.nk : ntfull;
        for (int t = 0; t < nt; t += 2) {
            const bool last = (t == nt - 2);
            const char* a1 = cA + (size_t)(t + 1) * kstep;
            const char* a2 = last ? nA : cA + (size_t)(t + 2) * kstep; const char* b2 = last ? nB : cB + (size_t)(t + 2) * kstep;
            const char* a3 = a2 + kstep; const char* b3 = b2 + kstep;
            if (last && has_next) S.a_ready(nxt);
            if constexpr (SP2) {
            PG8_LDB(B0, 0, 0); PG8_LDB(B1, 0, 1); PG8_SCHED; PG8_LDA(At, 0, 0); PG8_STAGE(PG8_SA(1, 1), a1 + hstep, voffA);
            PG8_WAIT_V(8); PG8_WAIT_L(0); PG8_BAR; PG8_MMA(0, 0, At, B0); PG8_MMA(0, 1, At, B1); PG8_BAR; PG8_SCHED;
            PG8_LDA(At, 0, 1); PG8_STAGE(PG8_SB(0, 0), b2, voffB); PG8_STAGE(PG8_SB(0, 1), b2 + hstep, voffB); PG8_STAGE(PG8_SA(0, 0), a2, voffA);
            PG8_WAIT_V(8); PG8_WAIT_L(0); PG8_BAR; PG8_MMA(1, 0, At, B0); PG8_MMA(1, 1, At, B1); PG8_BAR; PG8_SCHED;
            PG8_LDB(B0, 1, 0); PG8_LDB(B1, 1, 1); PG8_SCHED; PG8_LDA(At, 1, 0); PG8_STAGE(PG8_SA(0, 1), a2 + hstep, voffA);
            PG8_WAIT_V(8); PG8_WAIT_L(0); PG8_BAR; PG8_MMA(0, 0, At, B0); PG8_MMA(0, 1, At, B1); PG8_BAR; PG8_SCHED;
            PG8_LDA(At, 1, 1); PG8_STAGE(PG8_SB(1, 0), b3, voffB); PG8_STAGE(PG8_SB(1, 1), b3 + hstep, voffB); PG8_STAGE(PG8_SA(1, 0), a3, voffA);
            PG8_WAIT_V(8); PG8_WAIT_L(0); PG8_BAR; PG8_MMA(1, 0, At, B0); PG8_MMA(1, 1, At, B1); PG8_BAR; PG8_SCHED;
            } else {
            PG8_LDB(B0, 0, 0); PG8_SCHED; PG8_LDA(At, 0, 0); PG8_STAGE(PG8_SA(1, 1), a1 + hstep, voffA);
            PG8_WAIT_L(8); PG8_BAR; PG8_WAIT_L(0); PG8_MMA(0, 0, At, B0); PG8_BAR; PG8_SCHED;
            PG8_LDB(B1, 0, 1); PG8_STAGE(PG8_SB(0, 0), b2, voffB);
            PG8_BAR; PG8_WAIT_L(0); PG8_MMA(0, 1, At, B1); PG8_BAR;
            PG8_LDA(At, 0, 1); PG8_STAGE(PG8_SA(0, 0), a2, voffA);
            PG8_BAR; PG8_WAIT_L(0); PG8_MMA(1, 0, At, B0); PG8_BAR; PG8_SCHED;
            PG8_STAGE(PG8_SB(0, 1), b2 + hstep, voffB);
            PG8_WAIT_V(6); PG8_BAR; PG8_MMA(1, 1, At, B1); PG8_BAR;
            PG8_LDB(B0, 1, 0); PG8_SCHED; PG8_LDA(At, 1, 0); PG8_STAGE(PG8_SA(0, 1), a2 + hstep, voffA);
            PG8_WAIT_L(8); PG8_BAR; PG8_WAIT_L(0); PG8_MMA(0, 0, At, B0); PG8_BAR; PG8_SCHED;
            PG8_LDB(B1, 1, 1); PG8_STAGE(PG8_SB(1, 0), b3, voffB);
            PG8_BAR; PG8_WAIT_L(0); PG8_MMA(0, 1, At, B1); PG8_BAR;
            PG8_LDA(At, 1, 1); PG8_STAGE(PG8_SA(1, 0), a3, voffA);
            PG8_BAR; PG8_WAIT_L(0); PG8_MMA(1, 0, At, B0); PG8_BAR; PG8_SCHED;
            PG8_STAGE(PG8_SB(1, 1), b3 + hstep, voffB);
            PG8_WAIT_V(6); PG8_BAR; PG8_MMA(1, 1, At, B1); PG8_BAR;
            }
        }
        if constexpr (ALIGN_EPI) { if (wr == 0) PG8_BAR; }
        if constexpr (!Epi::AFTER_DRAIN) { E(acc, cur, wr, wc, fr, fq); S.done(cur); }
        if (!has_next) break;
#pragma unroll
        for (int a = 0; a < 2; ++a)
#pragma unroll
            for (int b = 0; b < 2; ++b)
#pragma unroll
                for (int m = 0; m < 4; ++m)
#pragma unroll
                    for (int n = 0; n < 2; ++n) acc[a][b][m][n] = (f32x4){0.f, 0.f, 0.f, 0.f};
        cur = nxt; cA = nA; cB = nB; ++ui;
        if constexpr (ALIGN_EPI) { if (wr == 1) PG8_BAR; }
    }
    PG8_WAIT_V(0);
    if constexpr (!ALIGN_EPI) { if (wr == 0) PG8_BAR; }
    PG8_BAR;
    if constexpr (Epi::AFTER_DRAIN) { E.fused(acc, cur, wr, wc, fr, fq, lds, wid, lane); S.done(cur); }
#undef PG8_SA
#undef PG8_SB
#undef PG8_STAGE
#undef PG8_LDA
#undef PG8_LDB
#undef PG8_MMA
#undef PG8_WAIT_V
#undef PG8_WAIT_L
#undef PG8_BAR
#undef PG8_SCHED
}
}

#ifndef MK_LAUNCHES
#define MK_LAUNCHES 1
#endif
#define LAS __attribute__((address_space(3)))
typedef unsigned short bf16;
using pg8::bf16x8; using pg8::f32x4; using pg8::u32x4; using pg8::Unit;
typedef __bf16 bf16x2_t __attribute__((ext_vector_type(2)));
typedef float f32x2_t __attribute__((ext_vector_type(2)));
__device__ __forceinline__ unsigned cvt_pk_bf16(float lo, float hi) { const f32x2_t f = {lo, hi}; const bf16x2_t b = __builtin_convertvector(f, bf16x2_t); return __builtin_bit_cast(unsigned, b); }
typedef unsigned u32x2 __attribute__((ext_vector_type(2)));
typedef float f32x2v __attribute__((ext_vector_type(2)));

constexpr int NT = 512;
constexpr int D = 1024, MP = 16384, MS = 1024, M = MP + MS, FF = 4096;
constexpr int NIN = 9248;
constexpr float EPS = 1e-6f;
constexpr int LDS_BYTES = 147456;
constexpr size_t O_CP = 17825792, O_SP = 17844224, O_CS = 18368512, O_SS = 18515968, O_VS = 22710272;
constexpr size_t HM = 512 * 1024;
constexpr size_t SH = 1032192;
constexpr size_t WS_WIN = 2 * HM - SH, WS_WA = 39 * HM - SH, WS_WB = 43 * HM - SH, WS_WO = 51 * HM - SH, WS_WUP = 55 * HM - SH, WS_WDN = 71 * HM - SH;
constexpr size_t WS_XN = 87 * HM - SH, WS_U = 155 * HM - SH, WS_G = 223 * HM - SH, WS_XBC = 291 * HM - SH;
constexpr size_t WS_VST = 495 * HM - SH, WS_DT = WS_VST + 2228224, WS_CD = WS_DT + 2228224, WS_ST = WS_CD + 8192, WS_ST2 = WS_ST  , WS_END = 512 * HM;
constexpr size_t WS_GABS = 504 * HM;
static_assert(WS_ST + 1114112 <= WS_GABS && WS_WIN == 16384, "tail of the d_ws map");
constexpr size_t WS_S = WS_G, WS_GAB = 223 * HM - SH, WS_T = 359 * HM - SH, WS_MG = WS_XN, WS_T2 = 223 * HM - SH, WS_X1N = 359 * HM - SH, WS_H = 87 * HM - SH, WS_F = 359 * HM - SH;
constexpr size_t WS_SLA = 427 * HM - SH, WS_SLB = 443 * HM - SH;
constexpr size_t WS_ACO = 427 * HM - SH, WS_ACF = 423 * HM - SH;

struct KP { const float* in[24]; float* out; unsigned char* ws; int ph_lo, ph_hi; };
enum { I_XP = 0, I_XS, I_CACHE, I_STATE, I_PREMIX, I_WIN, I_LNW, I_LNB, I_GWS, I_GBS, I_CONVW, I_CONVB, I_DTB, I_ALOG, I_DSKIP, I_SNW, I_WA, I_WB, I_WO, I_POSTMIX, I_PREFFN, I_WUP, I_WDN, I_POSTFFN };

__device__ __forceinline__ float bflo(unsigned w) { return __uint_as_float(w << 16); }
__device__ __forceinline__ float bfhi(unsigned w) { return __uint_as_float(w & 0xffff0000u); }
__device__ __forceinline__ float bf1(unsigned short b) { return __uint_as_float((unsigned)b << 16); }
__device__ __forceinline__ float fsigmoid(float x) { return __builtin_amdgcn_rcpf(1.f + __expf(-x)); }
__device__ __forceinline__ float fsilu(float x) { return x * fsigmoid(x); }
__device__ __forceinline__ float fgelu(float x) { const float t = x * (1.5957691216f + 0.0713548163f * x * x); return x * __builtin_amdgcn_rcpf(1.f + __expf(-t)); }
__device__ __forceinline__ float wave_sum(float v) {
#pragma unroll
    for (int o = 1; o < 64; o <<= 1) v += __shfl_xor(v, o);
    return v;
}
__device__ __forceinline__ u32x4 pack8(const float (&a)[8]) { u32x4 w; w.x = cvt_pk_bf16(a[0], a[1]); w.y = cvt_pk_bf16(a[2], a[3]); w.z = cvt_pk_bf16(a[4], a[5]); w.w = cvt_pk_bf16(a[6], a[7]); return w; }
__device__ __forceinline__ void unpack8(const u32x4 w, float (&a)[8]) { a[0] = bflo(w.x); a[1] = bfhi(w.x); a[2] = bflo(w.y); a[3] = bfhi(w.y); a[4] = bflo(w.z); a[5] = bfhi(w.z); a[6] = bflo(w.w); a[7] = bfhi(w.w); }
__device__ __forceinline__ const float* xrow(const KP& p, int m) { return m < MP ? p.in[I_XP] + (size_t)m * D : p.in[I_XS] + (size_t)(m - MP) * D; }

#define EPI_ROWS_BEGIN _Pragma("unroll") for (int ai = 0; ai < 2; ++ai) _Pragma("unroll") for (int m = 0; m < 4; ++m) { const int row = u.pm * 256 + ai * 128 + wr * 64 + m * 16 + fr;
#define EPI_COLS_BEGIN _Pragma("unroll") for (int bj = 0; bj < 2; ++bj) { const int col = u.pn * 256 + bj * 128 + wc * 32 + 8 * fq; \
        float v[8]; { const f32x4 v0 = acc[ai][bj][m][0], v1 = acc[ai][bj][m][1]; v[0] = v0[0]; v[1] = v0[1]; v[2] = v0[2]; v[3] = v0[3]; v[4] = v1[0]; v[5] = v1[1]; v[6] = v1[2]; v[7] = v1[3]; }
#define EPI_END }
typedef const f32x4 (&AccRef)[2][2][4][2];

struct EpiUV {
    static constexpr bool PERM = true, AFTER_DRAIN = false; bf16* U; bf16* G; f32x2v* VST;
    __device__ __forceinline__ void operator()(AccRef acc, const Unit& u, int wr, int wc, int fr, int fq) const {
        const bool isv = u.pn >= 4; bf16* base = isv ? G : U;
        EPI_ROWS_BEGIN float s = 0.f, s2 = 0.f;
            EPI_COLS_BEGIN
#pragma unroll
                for (int e = 0; e < 8; ++e) { v[e] = fgelu(v[e]); s += v[e]; s2 += v[e] * v[e]; }
                *(u32x4*)(base + (size_t)row * 1024 + (col & 1023)) = pack8(v);
            EPI_END
            if (isv) { s += __shfl_xor(s, 16); s += __shfl_xor(s, 32); s2 += __shfl_xor(s2, 16); s2 += __shfl_xor(s2, 32);
                if (fq == 0) VST[(size_t)row * 16 + (u.pn - 4) * 4 + wc] = (f32x2v){s, s2}; }
        EPI_END
    }
};
struct EpiZXD {
    static constexpr bool PERM = true, AFTER_DRAIN = false; bf16* Z; bf16* XBC; float* DT; const float* dtb; float* out;
    __device__ __forceinline__ void operator()(AccRef acc, const Unit& u, int wr, int wc, int fr, int fq) const {
        EPI_ROWS_BEGIN
            EPI_COLS_BEGIN
                if (u.pn < 8) {
#pragma unroll
                    for (int e = 0; e < 8; ++e) v[e] = fsilu(v[e]);
                    __builtin_nontemporal_store(pack8(v), (u32x4*)(Z + (size_t)row * 2048 + col));
                } else if (u.pn < 20) {
                    const int c = col - 2048;
                    *(u32x4*)(XBC + (size_t)row * 3072 + c) = pack8(v);
                    int k; size_t o;
                    if (row < MP) { k = (row & 8191) - 8189; o = O_CP + ((size_t)(row >> 13) * 3 + k) * 3072 + c; }
                    else { k = ((row - MP) & 63) - 61; o = O_CS + ((size_t)((row - MP) >> 6) * 3 + k) * 3072 + c; }
                    if (k >= 0) { *(f32x4*)(out + o) = (f32x4){v[0], v[1], v[2], v[3]}; *(f32x4*)(out + o + 4) = (f32x4){v[4], v[5], v[6], v[7]}; }
                } else if (bj == 0 && wc == 0) {
                    int c = 8 * fq; asm volatile("" : "+v"(c));
#pragma unroll
                    for (int e = 0; e < 8; ++e) { const float x = v[e] + dtb[c + e]; v[e] = x > 15.f ? x : log1pf(__expf(x)); }
                    *(f32x4*)(DT + (size_t)row * 32 + c) = (f32x4){v[0], v[1], v[2], v[3]}; *(f32x4*)(DT + (size_t)row * 32 + c + 4) = (f32x4){v[4], v[5], v[6], v[7]};
                }
            EPI_END
        EPI_END
    }
};
struct EpiG {
    static constexpr bool PERM = true, AFTER_DRAIN = false; bf16* GAB; int roff;
    __device__ __forceinline__ void operator()(AccRef acc, const Unit& u, int wr, int wc, int fr, int fq) const {
        EPI_ROWS_BEGIN EPI_COLS_BEGIN
#pragma unroll
            for (int e = 0; e < 8; ++e) v[e] = fsigmoid(v[e]);
            *(u32x4*)(GAB + (size_t)(row - roff) * 2048 + col) = pack8(v);
        EPI_END EPI_END
    }
};
struct EpiIn {
    static constexpr bool PERM = true, AFTER_DRAIN = false; EpiUV uv; EpiZXD zxd; EpiG gs;
    __device__ __forceinline__ void operator()(AccRef acc, const Unit& u, int wr, int wc, int fr, int fq) const {
        if (u.pn < 8) uv(acc, u, wr, wc, fr, fq);
        else if (u.pn < 29) { Unit v = u; v.pn = u.pn - 8; zxd(acc, v, wr, wc, fr, fq); }
        else { Unit v = u; v.pn = u.pn - 29; gs(acc, v, wr, wc, fr, fq); }
    }
};
struct EpiA {
    static constexpr bool PERM = true, AFTER_DRAIN = false; const bf16* GAB; const bf16* GABS; bf16* T;
    __device__ __forceinline__ void operator()(AccRef acc, const Unit& u, int wr, int wc, int fr, int fq) const {
        EPI_ROWS_BEGIN EPI_COLS_BEGIN
            float s[8]; unpack8(*(const u32x4*)((row < MP ? GAB + (size_t)row * 2048 : GABS + (size_t)(row - MP) * 2048) + col), s);
#pragma unroll
            for (int e = 0; e < 8; ++e) v[e] *= s[e];
            *(u32x4*)(T + (size_t)row * 1024 + col) = pack8(v);
        EPI_END EPI_END
    }
};
struct EpiB {
    static constexpr bool PERM = true, AFTER_DRAIN = false; const bf16* GAB; const bf16* GABS; const bf16* T; bf16* MG;
    __device__ __forceinline__ void operator()(AccRef acc, const Unit& u, int wr, int wc, int fr, int fq) const {
        EPI_ROWS_BEGIN EPI_COLS_BEGIN
            float s[8], t[8]; unpack8(*(const u32x4*)((row < MP ? GAB + (size_t)row * 2048 : GABS + (size_t)(row - MP) * 2048) + 1024 + col), s); unpack8(*(const u32x4*)(T + (size_t)row * 1024 + col), t);
#pragma unroll
            for (int e = 0; e < 8; ++e) v[e] = t[e] + s[e] * v[e];
            *(u32x4*)(MG + (size_t)row * 1024 + col) = pack8(v);
        EPI_END EPI_END
    }
};

struct EpiSq {
    static constexpr bool PERM = true, AFTER_DRAIN = false; bf16* O; float* ST;
    __device__ __forceinline__ void operator()(AccRef acc, const Unit& u, int wr, int wc, int fr, int fq) const {
        EPI_ROWS_BEGIN float s2 = 0.f;
            EPI_COLS_BEGIN
#pragma unroll
                for (int e = 0; e < 8; ++e) s2 += v[e] * v[e];
                *(u32x4*)(O + (size_t)row * 1024 + col) = pack8(v);
            EPI_END
            s2 += __shfl_xor(s2, 16); s2 += __shfl_xor(s2, 32);
            if (fq == 0) ST[(size_t)row * 16 + u.pn * 4 + wc] = s2;
        EPI_END
    }
};
struct EpiSqTail {
    static constexpr bool PERM = true, AFTER_DRAIN = false; EpiSq sq; float* SL; int kb_shift;
    __device__ __forceinline__ void operator()(AccRef acc, const Unit& u, int wr, int wc, int fr, int fq) const {
        if (u.nk == 0) { sq(acc, u, wr, wc, fr, fq); return; }
        float* base = SL + (size_t)(u.kb >> kb_shift) * (MS * D);
        EPI_ROWS_BEGIN EPI_COLS_BEGIN
            float* t = base + (size_t)(row - MP) * 1024 + col;
            *(f32x4*)t = (f32x4){v[0], v[1], v[2], v[3]}; *(f32x4*)(t + 4) = (f32x4){v[4], v[5], v[6], v[7]};
        EPI_END EPI_END
    }
};
struct EpiGen {
    static constexpr bool PERM = true, AFTER_DRAIN = false; int mode; const bf16* GAB; const bf16* T; bf16* O; float* ST; float* SL; int kb_shift;
    __device__ __forceinline__ void operator()(AccRef acc, const Unit& u, int wr, int wc, int fr, int fq) const {
        if (u.nk != 0) {
            float* base = SL + (size_t)(u.kb >> kb_shift) * (MS * D);
            EPI_ROWS_BEGIN EPI_COLS_BEGIN
                float* t = base + (size_t)(row - MP) * 1024 + col;
                *(f32x4*)t = (f32x4){v[0], v[1], v[2], v[3]}; *(f32x4*)(t + 4) = (f32x4){v[4], v[5], v[6], v[7]};
            EPI_END EPI_END
            return;
        }
        if (mode == 2) {
            EPI_ROWS_BEGIN float s2 = 0.f;
                EPI_COLS_BEGIN
#pragma unroll
                    for (int e = 0; e < 8; ++e) s2 += v[e] * v[e];
                    *(u32x4*)(O + (size_t)row * 1024 + col) = pack8(v);
                EPI_END
                s2 += __shfl_xor(s2, 16); s2 += __shfl_xor(s2, 32);
                if (fq == 0) ST[(size_t)row * 16 + u.pn * 4 + wc] = s2;
            EPI_END
            return;
        }
        if (mode == 3) {
            EPI_ROWS_BEGIN EPI_COLS_BEGIN
#pragma unroll
                for (int e = 0; e < 8; ++e) v[e] = fsigmoid(v[e]);
                *(u32x4*)(O + (size_t)row * 2048 + col) = pack8(v);
            EPI_END EPI_END
            return;
        }
        const int goff = mode ? 1024 : 0;
        EPI_ROWS_BEGIN EPI_COLS_BEGIN
            float s[8]; unpack8(*(const u32x4*)(GAB + (size_t)row * 2048 + goff + col), s);
            if (mode) { float t[8]; unpack8(*(const u32x4*)(T + (size_t)row * 1024 + col), t);
#pragma unroll
                for (int e = 0; e < 8; ++e) v[e] = t[e] + s[e] * v[e]; }
            else {
#pragma unroll
                for (int e = 0; e < 8; ++e) v[e] *= s[e]; }
            *(u32x4*)(O + (size_t)row * 1024 + col) = pack8(v);
        EPI_END EPI_END
    }
};
struct EpiUp {
    static constexpr bool PERM = true, AFTER_DRAIN = false; bf16* H;
    __device__ __forceinline__ void operator()(AccRef acc, const Unit& u, int wr, int wc, int fr, int fq) const {
        EPI_ROWS_BEGIN EPI_COLS_BEGIN
#pragma unroll
            for (int e = 0; e < 8; ++e) { const float r = fmaxf(v[e], 0.f); v[e] = r * r; }
            *(u32x4*)(H + (size_t)row * FF + col) = pack8(v);
        EPI_END EPI_END
    }
};

__device__ __forceinline__ void tr_item(const float* W, int K, int N, bf16* WT, const float* scale, bool winmap, LAS float* scr, int item, int lane) {
    const int nblk = N / 32, kb = item / nblk, nb = item % nblk, k0 = 64 * kb, n0 = 32 * nb;
    float wv[32];
#pragma unroll
    for (int i = 0; i < 32; ++i) wv[i] = __builtin_nontemporal_load(W + (size_t)(k0 + 2 * i + (lane >> 5)) * N + n0 + (lane & 31));
#pragma unroll
    for (int i = 0; i < 32; ++i) { const int kk = 2 * i + (lane >> 5); float v = wv[i]; if (scale) v *= scale[k0 + kk]; scr[kk * 33 + (lane & 31)] = v; }
    asm volatile("s_waitcnt lgkmcnt(0)" ::: "memory");
    const int c = lane & 7; const int rbase = (winmap && n0 >= 7200) ? n0 + 224 : n0;
#pragma unroll
    for (int j = 0; j < 4; ++j) { const int n = (lane >> 3) + 8 * j; const LAS float* s = scr + (8 * c) * 33 + n;
        u32x4 o; o.x = cvt_pk_bf16(s[0 * 33], s[1 * 33]); o.y = cvt_pk_bf16(s[2 * 33], s[3 * 33]); o.z = cvt_pk_bf16(s[4 * 33], s[5 * 33]); o.w = cvt_pk_bf16(s[6 * 33], s[7 * 33]);
        *(u32x4*)(WT + (size_t)(rbase + n) * K + k0 + 8 * c) = o; }
    asm volatile("s_waitcnt lgkmcnt(0)" ::: "memory");
}
__device__ __forceinline__ void phase_prologue(const KP& p, LAS unsigned char* lds, int wid, int lane, int part, int gw_ = -1, int ngw_ = 0) {
    LAS float* scr = (LAS float*)(lds + wid * 16384);
    const int gw = gw_ >= 0 ? gw_ : blockIdx.x * 8 + wid, NGW = gw_ >= 0 ? ngw_ : gridDim.x * 8;
    constexpr int I_IN = 16 * 289, I_A = 16 * 32, I_B = 32 * 32, I_O = 16 * 32, I_UP = 16 * 128, I_DN = 64 * 32;
    constexpr int NITEMS = I_IN + I_A + I_B + I_O + I_UP + I_DN;
    unsigned char* ws = p.ws;
#pragma clang loop unroll(disable)
    for (int it = (part ? I_IN : 0) + gw; it < (part ? NITEMS : I_IN); it += NGW) {
        int r = it; const float* W; int K, N; bf16* WT; const float* sc = nullptr; bool wm = false;
        if (r < I_IN) { W = p.in[I_WIN]; K = D; N = NIN; WT = (bf16*)(ws + WS_WIN); sc = p.in[I_PREMIX]; wm = true; }
        else if ((r -= I_IN) < I_A) { W = p.in[I_WA]; K = D; N = D; WT = (bf16*)(ws + WS_WA); }
        else if ((r -= I_A) < I_B) { W = p.in[I_WB]; K = 2048; N = D; WT = (bf16*)(ws + WS_WB); }
        else if ((r -= I_B) < I_O) { W = p.in[I_WO]; K = D; N = D; WT = (bf16*)(ws + WS_WO); }
        else if ((r -= I_O) < I_UP) { W = p.in[I_WUP]; K = D; N = FF; WT = (bf16*)(ws + WS_WUP); sc = p.in[I_PREFFN]; }
        else { r -= I_UP; W = p.in[I_WDN]; K = FF; N = D; WT = (bf16*)(ws + WS_WDN); }
        tr_item(W, K, N, WT, sc, wm, scr, r, lane);
    }
    if (part) return;
    bf16* XN = (bf16*)(ws + WS_XN);
    for (int m = gw; m < M; m += NGW) {
        const f32x4* xr = (const f32x4*)xrow(p, m) + lane; f32x4 v[4]; float s = 0.f;
#pragma unroll
        for (int j = 0; j < 4; ++j) { v[j] = __builtin_nontemporal_load(xr + 64 * j); s += (v[j][0] * v[j][0] + v[j][1] * v[j][1]) + (v[j][2] * v[j][2] + v[j][3] * v[j][3]); }
        const float r = rsqrtf(wave_sum(s) * (1.f / D) + EPS);
        u32x2* o = (u32x2*)(XN + (size_t)m * D) + lane;
#pragma unroll
        for (int j = 0; j < 4; ++j) { u32x2 w; w.x = cvt_pk_bf16(v[j][0] * r, v[j][1] * r); w.y = cvt_pk_bf16(v[j][2] * r, v[j][3] * r); o[64 * j] = w; }
    }
}

__device__ __forceinline__ void gmlp_unit(const KP& p, LAS unsigned char* lds, int ck, int g, int tid, int wid, int lane, bool dry = false) {
    LAS bf16* Wl = (LAS bf16*)lds;
    LAS bf16* Vt = (LAS bf16*)(lds + 34816);
    LAS f32x2v* RS = (LAS f32x2v*)(lds + 69632);
    const bool sample = ck >= 128; const int nrows = sample ? 64 : 128; const int row0 = sample ? MP + (ck - 128) * 64 : ck * 128;
    bf16* U = (bf16*)(p.ws + WS_U); const bf16* G = (const bf16*)(p.ws + WS_G); const f32x2v* VST = (const f32x2v*)(p.ws + WS_VST);
    const float* Wg = p.in[I_GWS] + (size_t)g * 16384;
#pragma unroll
    for (int it = 0; it < 8; ++it) { const int idx = tid + it * NT; const int i = idx >> 5, j4 = (idx & 31) * 4; const f32x4 w = *(const f32x4*)(Wg + i * 128 + j4);
        u32x2 o; o.x = cvt_pk_bf16(w[0], w[1]); o.y = cvt_pk_bf16(w[2], w[3]); *(LAS u32x2*)(Wl + i * 136 + j4) = o; }
    if (tid < nrows) { const f32x2v* s = VST + (size_t)(row0 + tid) * 16; float a = 0.f, b = 0.f;
#pragma unroll
        for (int t = 0; t < 16; ++t) { const f32x2v x = s[t]; a += x.x; b += x.y; }
        const float mean = a * (1.f / 1024.f); const float var = fmaxf(b * (1.f / 1024.f) - mean * mean, 0.f); RS[tid] = (f32x2v){mean, rsqrtf(var + EPS)}; }
    __syncthreads();
    for (int it = tid; it < nrows * 16; it += NT) { const int j = it >> 4, d8 = (it & 15) * 8; const int c = g * 128 + d8;
        float x[8]; unpack8(*(const u32x4*)(G + (size_t)(row0 + j) * 1024 + c), x);
        const f32x2v rs = RS[j]; const f32x4 w0 = *(const f32x4*)(p.in[I_LNW] + c), w1 = *(const f32x4*)(p.in[I_LNW] + c + 4), b0 = *(const f32x4*)(p.in[I_LNB] + c), b1 = *(const f32x4*)(p.in[I_LNB] + c + 4);
        const float lw[8] = {w0[0], w0[1], w0[2], w0[3], w1[0], w1[1], w1[2], w1[3]}, lb[8] = {b0[0], b0[1], b0[2], b0[3], b1[0], b1[1], b1[2], b1[3]};
#pragma unroll
        for (int e = 0; e < 8; ++e) { x[e] = (x[e] - rs.x) * rs.y * lw[e] + lb[e]; Vt[(d8 + e) * 136 + j] = (bf16)(cvt_pk_bf16(x[e], 0.f) & 0xffffu); }
        if (sample && !dry) { float* o = p.out + O_VS + ((size_t)(ck - 128) * 64 + j) * 1024 + c; *(f32x4*)o = (f32x4){x[0], x[1], x[2], x[3]}; *(f32x4*)(o + 4) = (f32x4){x[4], x[5], x[6], x[7]}; }
    }
    __syncthreads();
    const int fr = lane & 15, q = lane >> 4; const int ibl = wid >> 1, ds0 = (wid & 1) * 4;
    f32x4 alo[4], ahi[4];
#pragma unroll
    for (int d = 0; d < 4; ++d) { alo[d] = (f32x4){0.f, 0.f, 0.f, 0.f}; ahi[d] = (f32x4){0.f, 0.f, 0.f, 0.f}; }
#pragma unroll
    for (int ks = 0; ks < 4; ++ks) {
        if (ks >= 2 && sample) break;
        bf16x8 X[4];
#pragma unroll
        for (int d = 0; d < 4; ++d) X[d] = *(const LAS bf16x8*)(Vt + ((ds0 + d) * 16 + fr) * 136 + ks * 32 + 8 * q);
        if (ks < 2) { const bf16x8 Y = *(const LAS bf16x8*)(Wl + (ibl * 16 + fr) * 136 + ks * 32 + 8 * q);
#pragma unroll
            for (int d = 0; d < 4; ++d) alo[d] = __builtin_amdgcn_mfma_f32_16x16x32_bf16(X[d], Y, alo[d], 0, 0, 0); }
        if (!sample) { const bf16x8 Y = *(const LAS bf16x8*)(Wl + ((4 + ibl) * 16 + fr) * 136 + ks * 32 + 8 * q);
#pragma unroll
            for (int d = 0; d < 4; ++d) ahi[d] = __builtin_amdgcn_mfma_f32_16x16x32_bf16(X[d], Y, ahi[d], 0, 0, 0); }
    }
#pragma unroll
    for (int hh = 0; hh < 2; ++hh) {
        if (hh == 1 && sample) break;
        const int i = (hh * 4 + ibl) * 16 + fr; const float bsv = p.in[I_GBS][g * 128 + i];
#pragma unroll
        for (int d = 0; d < 4; ++d) { const f32x4 a = hh ? ahi[d] : alo[d]; bf16* up = U + (size_t)(row0 + i) * 1024 + g * 128 + (ds0 + d) * 16 + 4 * q;
            const u32x2 uu = *(const u32x2*)up; u32x2 o; o.x = cvt_pk_bf16(bflo(uu.x) * (a[0] + bsv), bfhi(uu.x) * (a[1] + bsv)); o.y = cvt_pk_bf16(bflo(uu.y) * (a[2] + bsv), bfhi(uu.y) * (a[3] + bsv));
            if (!dry) *(u32x2*)up = o; }
    }
    __syncthreads();
}

__device__ __forceinline__ u32x4 ssd_load8(const KP& p, const bf16* XBC, int seq, int rowbase, int trel, int ch) {
    if (trel >= 0) return *(const u32x4*)(XBC + (size_t)(rowbase + trel) * 3072 + ch);
    if (seq >= 2) { const float* h = p.in[I_CACHE] + ((size_t)(seq - 2) * 3 + (trel + 3)) * 3072 + ch; const f32x4 a = *(const f32x4*)h, b = *(const f32x4*)(h + 4);
        return (u32x4){cvt_pk_bf16(a[0], a[1]), cvt_pk_bf16(a[2], a[3]), cvt_pk_bf16(b[0], b[1]), cvt_pk_bf16(b[2], b[3])}; }
    return (u32x4){0u, 0u, 0u, 0u};
}
__device__ __forceinline__ u32x2 ld8_agent(const bf16* q) { const unsigned long long v = __hip_atomic_load((const unsigned long long*)q, __ATOMIC_RELAXED, __HIP_MEMORY_SCOPE_AGENT); return (u32x2){(unsigned)v, (unsigned)(v >> 32)}; }
__device__ __forceinline__ void st8_agent(bf16* q, u32x2 w) { __hip_atomic_store((unsigned long long*)q, ((unsigned long long)w.y << 32) | w.x, __ATOMIC_RELAXED, __HIP_MEMORY_SCOPE_AGENT); }
template <bool WITH_Y, bool SAMPLE>
__device__ __forceinline__ void ssd_unit(const KP& p, LAS unsigned char* lds, int seq, int sc, int g, int tid, int wid, int lane, bool dry = false) {
    LAS bf16* XT = (LAS bf16*)lds;
    LAS bf16* BT = (LAS bf16*)(lds + 73728);
    LAS bf16* Cs = (LAS bf16*)(lds + 92160);
    LAS bf16* Bs = (LAS bf16*)(lds + 109568);
    LAS float* CBs = (LAS float*)(lds + 109568);
    LAS float* ACUM = (LAS float*)(lds + 126976);
    LAS float* DTL = ACUM + 512;
    LAS float* NP = DTL + 512;
    constexpr bool sample = SAMPLE; const int rowbase = sample ? MP + (seq - 2) * 64 : seq * 8192; constexpr int nch = sample ? 1 : 4; const int c0 = sc * 4;
    const int h = g * 8 + wid; const float a_h = -__expf(p.in[I_ALOG][h]); const float Dh = p.in[I_DSKIP][h];
    const int fr = lane & 15, q = lane >> 4;
    const bf16* XBC = (const bf16*)(p.ws + WS_XBC); const float* DT = (const float*)(p.ws + WS_DT);
    bf16* Zb = (bf16*)p.out; bf16* Sb = (bf16*)(p.ws + WS_S); float* CD = (float*)(p.ws + WS_CD);
    const float* cw = p.in[I_CONVW]; const float* cb = p.in[I_CONVB];
    u32x4 hs[4][4];
#pragma unroll
    for (int pb = 0; pb < 4; ++pb)
#pragma unroll
        for (int t = 0; t < 4; ++t) hs[pb][t] = (u32x4){0u, 0u, 0u, 0u};
    bf16* Sent = Sb + ((size_t)(seq * 32 + sc) * 32 + h) * 8192 + (size_t)fr * 128 + 4 * q;
    const float* Hin = p.in[I_STATE] + ((size_t)((sample ? seq - 2 : 0) * 32 + h) * 64 + fr) * 128 + 4 * q;
    float lastsum = 0.f;
#pragma unroll 1
    for (int cc = 0; cc < nch; ++cc) {
        const int cidx = c0 + cc; const int r0 = rowbase + cidx * 64;
        bf16* zrow = Zb + (size_t)(r0 + fr) * 2048 + h * 64 + 4 * q; bf16* sentc = Sent;
        asm volatile("" : "+v"(zrow), "+v"(sentc));
        const float dtv = DT[(size_t)(r0 + lane) * 32 + h];
        const int chl = wid * 64 + (lane & 7) * 8, j0 = (lane >> 3) * 8; int ch = g * 512 + chl;
        const int oct2 = tid & 31, seg2 = tid >> 5; const bool isC = oct2 >= 16; const bool bc_on = WITH_Y || !isC;
        const int nl = (oct2 & 15) * 8, j02 = seg2 * 4; int ch2 = 2048 + (isC ? 512 : 0) + g * 128 + nl;
        asm volatile("" : "+v"(ch), "+v"(ch2));
        u32x4 rawx[11], rawb[7];
#pragma unroll
        for (int r = 0; r < 11; ++r) rawx[r] = ssd_load8(p, XBC, seq, rowbase, cidx * 64 + j0 - 3 + r, ch);
        if (bc_on) {
#pragma unroll
            for (int r = 0; r < 7; ++r) rawb[r] = ssd_load8(p, XBC, seq, rowbase, cidx * 64 + j02 - 3 + r, ch2); }
        float acum = dtv * a_h;
#pragma unroll
        for (int o = 1; o < 64; o <<= 1) { const float t = __shfl_up(acum, o); if (lane >= o) acum += t; }
        const float last = __shfl(acum, 63);
        ACUM[wid * 64 + lane] = acum; DTL[wid * 64 + lane] = dtv;
        {
#pragma unroll
            for (int hf = 0; hf < 2; ++hf) {
                const int c4 = ch + 4 * hf;
                const f32x4 w0 = *(const f32x4*)(cw + c4), w1 = *(const f32x4*)(cw + 3072 + c4), w2 = *(const f32x4*)(cw + 6144 + c4), w3 = *(const f32x4*)(cw + 9216 + c4), bb = *(const f32x4*)(cb + c4);
                f32x4 x0, x1, x2, prev; unsigned pk[4][4];
#pragma unroll
                for (int r = 0; r < 11; ++r) {
                    const u32x4 rw = rawx[r];
                    const unsigned ra = hf ? rw.z : rw.x, rb = hf ? rw.w : rw.y; const f32x4 cur = (f32x4){bflo(ra), bfhi(ra), bflo(rb), bfhi(rb)};
                    if (r >= 3) { f32x4 t = bb + w0 * x0 + w1 * x1 + w2 * x2 + w3 * cur;
#pragma unroll
                        for (int e = 0; e < 4; ++e) t[e] = fsilu(t[e]);
                        if ((r - 3) & 1) {
#pragma unroll
                            for (int e = 0; e < 4; ++e) pk[e][(r - 3) >> 1] = cvt_pk_bf16(prev[e], t[e]); }
                        else prev = t; }
                    x0 = x1; x1 = x2; x2 = cur;
                }
#pragma unroll
                for (int e = 0; e < 4; ++e) *(LAS u32x4*)(XT + (size_t)(chl + 4 * hf + e) * 72 + j0) = (u32x4){pk[e][0], pk[e][1], pk[e][2], pk[e][3]};
                asm volatile("" ::: "memory");
            }
        }
        if (bc_on) {
#pragma unroll
            for (int hf = 0; hf < 2; ++hf) {
                const int c4 = ch2 + 4 * hf;
                const f32x4 w0 = *(const f32x4*)(cw + c4), w1 = *(const f32x4*)(cw + 3072 + c4), w2 = *(const f32x4*)(cw + 6144 + c4), w3 = *(const f32x4*)(cw + 9216 + c4), bb = *(const f32x4*)(cb + c4);
                f32x4 x0, x1, x2, o[4];
#pragma unroll
                for (int r = 0; r < 7; ++r) {
                    const unsigned ra = hf ? rawb[r].z : rawb[r].x, rb = hf ? rawb[r].w : rawb[r].y; const f32x4 cur = (f32x4){bflo(ra), bfhi(ra), bflo(rb), bfhi(rb)};
                    if (r >= 3) { f32x4 t = bb + w0 * x0 + w1 * x1 + w2 * x2 + w3 * cur;
#pragma unroll
                        for (int e = 0; e < 4; ++e) t[e] = fsilu(t[e]);
                        o[r - 3] = t; }
                    x0 = x1; x1 = x2; x2 = cur;
                }
                if (WITH_Y) {
#pragma unroll
                    for (int jj = 0; jj < 4; ++jj) *(LAS u32x2*)((isC ? Cs : Bs) + (j02 + jj) * 136 + nl + 4 * hf) = (u32x2){cvt_pk_bf16(o[jj][0], o[jj][1]), cvt_pk_bf16(o[jj][2], o[jj][3])};
                }
                if (!isC) {
#pragma unroll
                    for (int e = 0; e < 4; ++e) *(LAS u32x2*)(BT + (nl + 4 * hf + e) * 72 + j02) = (u32x2){cvt_pk_bf16(o[0][e], o[1][e]), cvt_pk_bf16(o[2][e], o[3][e])};
                }
                asm volatile("" ::: "memory");
            }
        }
        __syncthreads();
        LAS bf16* XTh = XT + wid * 64 * 72;
        if (WITH_Y) {
            const int ibc = wid >> 1, jb0 = (wid & 1) * 2; f32x4 cbt[2];
#pragma unroll
            for (int jt = 0; jt < 2; ++jt) { cbt[jt] = (f32x4){0.f, 0.f, 0.f, 0.f}; const int jb = jb0 + jt;
                if (jb <= ibc) {
#pragma unroll
                    for (int ks = 0; ks < 4; ++ks) { const bf16x8 X = *(const LAS bf16x8*)(Bs + (jb * 16 + fr) * 136 + ks * 32 + 8 * q), Y = *(const LAS bf16x8*)(Cs + (ibc * 16 + fr) * 136 + ks * 32 + 8 * q);
                        cbt[jt] = __builtin_amdgcn_mfma_f32_16x16x32_bf16(X, Y, cbt[jt], 0, 0, 0); } } }
            __syncthreads();
#pragma unroll
            for (int jt = 0; jt < 2; ++jt) *(LAS f32x4*)(CBs + (ibc * 16 + fr) * 68 + (jb0 + jt) * 16 + 4 * q) = cbt[jt];
            __syncthreads();
            f32x4 ya[4][4];
#pragma unroll
            for (int pb = 0; pb < 4; ++pb)
#pragma unroll
                for (int ib = 0; ib < 4; ++ib) ya[pb][ib] = (f32x4){0.f, 0.f, 0.f, 0.f};
#ifndef NO_YOFF
#pragma unroll
            for (int t = 0; t < 4; ++t) {
                u32x4 hf4[4];
#pragma unroll
                for (int pb = 0; pb < 4; ++pb) {
                    if (sample) { const f32x4 a = *(const f32x4*)(Hin + pb * 2048 + 32 * t), b = *(const f32x4*)(Hin + pb * 2048 + 32 * t + 16); hf4[pb] = (u32x4){cvt_pk_bf16(a[0], a[1]), cvt_pk_bf16(a[2], a[3]), cvt_pk_bf16(b[0], b[1]), cvt_pk_bf16(b[2], b[3])}; }
                    else { const u32x2 a = *(const u32x2*)(sentc + pb * 2048 + 32 * t), b = *(const u32x2*)(sentc + pb * 2048 + 32 * t + 16); hf4[pb] = (u32x4){a.x, a.y, b.x, b.y}; } }
#pragma unroll
                for (int ib = 0; ib < 4; ++ib) { const u32x2 ca = *(const LAS u32x2*)(Cs + (ib * 16 + fr) * 136 + 32 * t + 4 * q), cb2 = *(const LAS u32x2*)(Cs + (ib * 16 + fr) * 136 + 32 * t + 16 + 4 * q);
                    const bf16x8 Y = __builtin_bit_cast(bf16x8, ((u32x4){ca.x, ca.y, cb2.x, cb2.y}));
#pragma unroll
                    for (int pb = 0; pb < 4; ++pb) ya[pb][ib] = __builtin_amdgcn_mfma_f32_16x16x32_bf16(__builtin_bit_cast(bf16x8, hf4[pb]), Y, ya[pb][ib], 0, 0, 0); }
                asm volatile("" ::: "memory"); }
#pragma unroll
            for (int ib = 0; ib < 4; ++ib) { const float ea = __expf(ACUM[wid * 64 + ib * 16 + fr]);
#pragma unroll
                for (int pb = 0; pb < 4; ++pb) ya[pb][ib] = ya[pb][ib] * ea; }
#endif
            u32x2 zz[4][4];
#pragma unroll
            for (int ib = 0; ib < 4; ++ib)
#pragma unroll
                for (int pb = 0; pb < 4; ++pb) zz[ib][pb] = *(const u32x2*)(zrow + ib * 32768 + pb * 16);
#ifndef NO_YDIAG
#pragma unroll
            for (int ib = 0; ib < 4; ++ib)
#pragma unroll
                for (int ks = 0; ks < 2; ++ks) {
                    if (ks == 1 && ib < 2) continue;
                    const int i = ib * 16 + fr, js0 = ks * 32 + 8 * q; const float ai = ACUM[wid * 64 + i];
                    const f32x4 c0v = *(const LAS f32x4*)(CBs + i * 68 + js0), c1v = *(const LAS f32x4*)(CBs + i * 68 + js0 + 4);
                    const f32x4 a0 = *(const LAS f32x4*)(ACUM + wid * 64 + js0), a1 = *(const LAS f32x4*)(ACUM + wid * 64 + js0 + 4);
                    const f32x4 d0 = *(const LAS f32x4*)(DTL + wid * 64 + js0), d1 = *(const LAS f32x4*)(DTL + wid * 64 + js0 + 4);
                    float l[8];
#pragma unroll
                    for (int e = 0; e < 4; ++e) { l[e] = (js0 + e <= i) ? c0v[e] * __expf(ai - a0[e]) * d0[e] : 0.f; l[4 + e] = (js0 + 4 + e <= i) ? c1v[e] * __expf(ai - a1[e]) * d1[e] : 0.f; }
                    const bf16x8 Y = __builtin_bit_cast(bf16x8, pack8(l));
#pragma unroll
                    for (int pb = 0; pb < 4; ++pb) { const bf16x8 X = *(const LAS bf16x8*)(XTh + (pb * 16 + fr) * 72 + js0); ya[pb][ib] = __builtin_amdgcn_mfma_f32_16x16x32_bf16(X, Y, ya[pb][ib], 0, 0, 0); }
                    asm volatile("" ::: "memory");
                }
#endif
            float ss[4];
#pragma unroll
            for (int ib = 0; ib < 4; ++ib) { const int i = ib * 16 + fr; ss[ib] = 0.f;
#pragma unroll
                for (int pb = 0; pb < 4; ++pb) { const int pc = pb * 16 + 4 * q; const u32x2 z2 = zz[ib][pb];
                    const float zf[4] = {bflo(z2.x), bfhi(z2.x), bflo(z2.y), bfhi(z2.y)};
#pragma unroll
                    for (int jj = 0; jj < 4; ++jj) { const float xs = bf1(XTh[(pc + jj) * 72 + i]); const float gv = (ya[pb][ib][jj] + Dh * xs) * zf[jj]; ya[pb][ib][jj] = gv; ss[ib] += gv * gv; } }
                asm volatile("" ::: "memory");
                ss[ib] += __shfl_xor(ss[ib], 16); ss[ib] += __shfl_xor(ss[ib], 32);
                if (q == 0) NP[wid * 64 + i] = ss[ib]; }
            __syncthreads();
            f32x4 wv4[4];
#pragma unroll
            for (int pb = 0; pb < 4; ++pb) wv4[pb] = *(const f32x4*)(p.in[I_SNW] + h * 64 + pb * 16 + 4 * q);
#pragma unroll
            for (int ib = 0; ib < 4; ++ib) { const int i = ib * 16 + fr; float tot = 0.f;
#pragma unroll
                for (int w8 = 0; w8 < 8; ++w8) tot += NP[w8 * 64 + i];
                const float rstd = rsqrtf(tot * (1.f / 512.f) + EPS);
#pragma unroll
                for (int pb = 0; pb < 4; ++pb) { const int pc = pb * 16 + 4 * q; const f32x4 wv = wv4[pb];
                    float ov[4] = {ya[pb][ib][0] * rstd * wv[0], ya[pb][ib][1] * rstd * wv[1], ya[pb][ib][2] * rstd * wv[2], ya[pb][ib][3] * rstd * wv[3]};
#ifdef NAN_DBG
#pragma unroll
                    for (int e = 0; e < 4; ++e) ov[e] = (fabsf(ov[e]) < 1e30f) ? ov[e] : 0.f;
#endif
                    u32x2 o; o.x = cvt_pk_bf16(ov[0], ov[1]); o.y = cvt_pk_bf16(ov[2], ov[3]);
                    if (!dry) *(u32x2*)(zrow + ib * 32768 + pb * 16) = o; } }
        }
#ifndef NO_F
        if (!WITH_Y || sample || cc + 1 < nch) {
            const float e_last = __expf(last);
            bf16x8 Ys[4][2];
#pragma unroll
            for (int ks = 0; ks < 2; ++ks) { const int js0 = ks * 32 + 8 * q;
                const f32x4 a0 = *(const LAS f32x4*)(ACUM + wid * 64 + js0), a1 = *(const LAS f32x4*)(ACUM + wid * 64 + js0 + 4);
                const f32x4 d0 = *(const LAS f32x4*)(DTL + wid * 64 + js0), d1 = *(const LAS f32x4*)(DTL + wid * 64 + js0 + 4);
                float wj[8];
#pragma unroll
                for (int e = 0; e < 4; ++e) { wj[e] = d0[e] * __expf(last - a0[e]); wj[4 + e] = d1[e] * __expf(last - a1[e]); }
#pragma unroll
                for (int pb = 0; pb < 4; ++pb) { float x[8]; unpack8(*(const LAS u32x4*)(XTh + (pb * 16 + fr) * 72 + js0), x);
#pragma unroll
                    for (int e = 0; e < 8; ++e) x[e] *= wj[e];
                    Ys[pb][ks] = __builtin_bit_cast(bf16x8, pack8(x)); } }
#pragma unroll
            for (int t = 0; t < 4; ++t) {
                u32x2 oldp[2][4]; f32x4 olds[2][4];
#pragma unroll
                for (int hf = 0; hf < 2; ++hf)
#pragma unroll
                    for (int pb = 0; pb < 4; ++pb) {
                        if (sample) olds[hf][pb] = *(const f32x4*)(Hin + pb * 2048 + (2 * t + hf) * 16);
                        else if (WITH_Y) oldp[hf][pb] = *(const u32x2*)(sentc + pb * 2048 + (2 * t + hf) * 16); }
#pragma unroll
                for (int hf = 0; hf < 2; ++hf) { const int nb = 2 * t + hf;
                    const bf16x8 X0 = *(const LAS bf16x8*)(BT + (nb * 16 + fr) * 72 + 8 * q), X1 = *(const LAS bf16x8*)(BT + (nb * 16 + fr) * 72 + 32 + 8 * q);
#pragma unroll
                    for (int pb = 0; pb < 4; ++pb) {
                        f32x4 a;
                        if (sample) { a = olds[hf][pb] * e_last; }
                        else if (WITH_Y) { const u32x2 w = oldp[hf][pb]; a = (f32x4){bflo(w.x), bfhi(w.x), bflo(w.y), bfhi(w.y)} * e_last; }
                        else { const unsigned w0 = hf ? hs[pb][t].z : hs[pb][t].x, w1 = hf ? hs[pb][t].w : hs[pb][t].y; a = (f32x4){bflo(w0), bfhi(w0), bflo(w1), bfhi(w1)} * e_last; }
                        a = __builtin_amdgcn_mfma_f32_16x16x32_bf16(X0, Ys[pb][0], a, 0, 0, 0);
                        a = __builtin_amdgcn_mfma_f32_16x16x32_bf16(X1, Ys[pb][1], a, 0, 0, 0);
                        if (sample) { if (!dry) *(f32x4*)(p.out + O_SS + (((size_t)(seq - 2) * 32 + h) * 64 + pb * 16 + fr) * 128 + nb * 16 + 4 * q) = a; }
                        else if (WITH_Y) { if (!dry) *(u32x2*)(sentc + pb * 2048 + nb * 16) = (u32x2){cvt_pk_bf16(a[0], a[1]), cvt_pk_bf16(a[2], a[3])}; }
                        else { const unsigned w0 = cvt_pk_bf16(a[0], a[1]), w1 = cvt_pk_bf16(a[2], a[3]); if (hf) { hs[pb][t].z = w0; hs[pb][t].w = w1; } else { hs[pb][t].x = w0; hs[pb][t].y = w1; } }
                    } }
                asm volatile("" ::: "memory"); }
        }
#endif
        lastsum += last;
        __syncthreads();
    }
    if (!WITH_Y) {
#pragma unroll
        for (int pb = 0; pb < 4; ++pb)
#pragma unroll
            for (int t = 0; t < 4; ++t) { bf16* s0 = Sb + (((size_t)(seq * 32 + sc) * 32 + h) * 64 + pb * 16 + fr) * 128 + 32 * t + 4 * q;
                *(u32x2*)s0 = (u32x2){hs[pb][t].x, hs[pb][t].y}; *(u32x2*)(s0 + 16) = (u32x2){hs[pb][t].z, hs[pb][t].w}; }
        if (lane == 0) CD[(seq * 32 + sc) * 32 + h] = lastsum;
    }
}

__device__ __forceinline__ void phase_scan(const KP& p, int tid, bool dry = false) {
    asm volatile("" : "+v"(tid));
    const int gid = blockIdx.x * NT + tid;
    if (gid >= 131072) return;
    const int seq = gid >> 16, rem = gid & 65535, h = rem >> 11;
    bf16* Sb = (bf16*)(p.ws + WS_S); const float* CD = (const float*)(p.ws + WS_CD);
    f32x4 hv = (f32x4){0.f, 0.f, 0.f, 0.f};
    u32x2 sv[32]; float ev[32];
#pragma unroll
    for (int sc = 0; sc < 32; ++sc) { sv[sc] = *(const u32x2*)(Sb + (size_t)(seq * 32 + sc) * 262144 + (size_t)rem * 4); ev[sc] = CD[(seq * 32 + sc) * 32 + h]; }
#pragma unroll
    for (int sc = 0; sc < 32; ++sc) {
        u32x2* sp = (u32x2*)(Sb + (size_t)(seq * 32 + sc) * 262144 + (size_t)rem * 4);
        const u32x2 s = sv[sc]; const float e = __expf(ev[sc]);
        if (!dry) *sp = (u32x2){cvt_pk_bf16(hv[0], hv[1]), cvt_pk_bf16(hv[2], hv[3])};
        hv = hv * e + (f32x4){bflo(s.x), bfhi(s.x), bflo(s.y), bfhi(s.y)};
    }
    if (!dry) *(f32x4*)(p.out + O_SP + (size_t)seq * 262144 + (size_t)rem * 4) = hv;
}

__device__ __forceinline__ float load_row_sq(f32x4 (&t)[4], const bf16* O, const float* ST, const float* SL, int ns, int m, int lane) {
    float s = 0.f;
    if (m < MP) { const u32x2* r = (const u32x2*)(O + (size_t)m * D) + lane;
#pragma unroll
        for (int j = 0; j < 4; ++j) { const u32x2 w = r[64 * j]; t[j] = (f32x4){bflo(w.x), bfhi(w.x), bflo(w.y), bfhi(w.y)}; }
        s = lane < 16 ? ST[(size_t)m * 16 + lane] : 0.f;
    } else {
#pragma unroll
        for (int j = 0; j < 4; ++j) t[j] = (f32x4){0.f, 0.f, 0.f, 0.f};
        for (int k = 0; k < ns; ++k) { const f32x4* r = (const f32x4*)(SL + ((size_t)k * MS + (m - MP)) * D) + lane;
#pragma unroll
            for (int j = 0; j < 4; ++j) t[j] = t[j] + r[64 * j]; }
#pragma unroll
        for (int j = 0; j < 4; ++j) s += (t[j][0] * t[j][0] + t[j][1] * t[j][1]) + (t[j][2] * t[j][2] + t[j][3] * t[j][3]);
    }
    return wave_sum(s);
}
__device__ __forceinline__ void phase_mgs(const KP& p, int wid, int lane) {
    asm volatile("" : "+v"(lane));
    const int gw = blockIdx.x * 8 + wid, NGW = gridDim.x * 8;
    const float* SLA = (const float*)(p.ws + WS_SLA); const float* SLB = (const float*)(p.ws + WS_SLB); const bf16* GS = (const bf16*)(p.ws + WS_GABS); bf16* MG = (bf16*)(p.ws + WS_T);
    for (int m = gw; m < MS; m += NGW) {
#pragma unroll
        for (int j = 0; j < 4; ++j) { const int col = 4 * lane + 256 * j;
            f32x4 pa = *(const f32x4*)(SLA + (size_t)m * D + col) + *(const f32x4*)(SLA + ((size_t)MS + m) * D + col);
            f32x4 pb = (*(const f32x4*)(SLB + (size_t)m * D + col) + *(const f32x4*)(SLB + ((size_t)MS + m) * D + col)) + (*(const f32x4*)(SLB + ((size_t)2 * MS + m) * D + col) + *(const f32x4*)(SLB + ((size_t)3 * MS + m) * D + col));
            const u32x2 a = *(const u32x2*)(GS + (size_t)m * 2048 + col), b = *(const u32x2*)(GS + (size_t)m * 2048 + 1024 + col);
            const f32x4 sa = (f32x4){bflo(a.x), bfhi(a.x), bflo(a.y), bfhi(a.y)}, sb = (f32x4){bflo(b.x), bfhi(b.x), bflo(b.y), bfhi(b.y)};
            const f32x4 o = sa * pa + sb * pb;
            *(u32x2*)(MG + (size_t)(MP + m) * D + col) = (u32x2){cvt_pk_bf16(o[0], o[1]), cvt_pk_bf16(o[2], o[3])}; }
    }
}
__device__ __forceinline__ void phase_x1(const KP& p, int wid, int lane) {
    asm volatile("" : "+v"(lane));
    const int gw = blockIdx.x * 8 + wid, NGW = gridDim.x * 8;
    bf16* X1N = (bf16*)(p.ws + WS_X1N);
    for (int m = gw; m < M; m += NGW) {
        f32x4 t[4]; const float rstd = rsqrtf(load_row_sq(t, (const bf16*)(p.ws + WS_T2), (const float*)(p.ws + WS_ST), (const float*)(p.ws + WS_ACO), 4, m, lane) * (1.f / D) + EPS);
        const f32x4* xr = (const f32x4*)xrow(p, m) + lane; const f32x4* wr4 = (const f32x4*)p.in[I_POSTMIX] + lane;
        f32x4 v[4]; float s2 = 0.f;
#pragma unroll
        for (int j = 0; j < 4; ++j) { v[j] = __builtin_nontemporal_load(xr + 64 * j) + t[j] * rstd * wr4[64 * j]; s2 += (v[j][0] * v[j][0] + v[j][1] * v[j][1]) + (v[j][2] * v[j][2] + v[j][3] * v[j][3]); }
        const float r2 = rsqrtf(wave_sum(s2) * (1.f / D) + EPS);
        f32x4* o = (f32x4*)(p.out + (size_t)m * D) + lane; u32x2* o2 = (u32x2*)(X1N + (size_t)m * D) + lane;
#pragma unroll
        for (int j = 0; j < 4; ++j) { __builtin_nontemporal_store(v[j], o + 64 * j); u32x2 w; w.x = cvt_pk_bf16(v[j][0] * r2, v[j][1] * r2); w.y = cvt_pk_bf16(v[j][2] * r2, v[j][3] * r2); o2[64 * j] = w; }
    }
}
__device__ __forceinline__ void phase_final(const KP& p, int wid, int lane) {
    asm volatile("" : "+v"(lane));
    const int gw = blockIdx.x * 8 + wid, NGW = gridDim.x * 8;
    for (int m = gw; m < M; m += NGW) {
        f32x4 t[4]; const float rstd = rsqrtf(load_row_sq(t, (const bf16*)(p.ws + WS_F), (const float*)(p.ws + WS_ST2), (const float*)(p.ws + WS_ACF), 8, m, lane) * (1.f / D) + EPS);
        f32x4* o = (f32x4*)(p.out + (size_t)m * D) + lane; const f32x4* wr4 = (const f32x4*)p.in[I_POSTFFN] + lane;
#pragma unroll
        for (int j = 0; j < 4; ++j) __builtin_nontemporal_store(o[64 * j] + t[j] * rstd * wr4[64 * j], o + 64 * j);
    }
}
__device__ __forceinline__ void zero_f32(float* q, int n4, int tid) {
    asm volatile("" : "+v"(tid));
    for (int i = blockIdx.x * NT + tid; i < n4; i += gridDim.x * NT) ((f32x4*)q)[i] = (f32x4){0.f, 0.f, 0.f, 0.f};
}

#define XB_TMO      128
#define XB_XCNT(j)  (256  + 64 * (j))
#define XB_XSUB(j)  (1280 + 64 * (j))
#define XB_XGEN(j)  (2304 + 64 * (j))
#define XB_TOP      3328
#define XB_TOPGEN   3392
#define XCD_BAR_WORDS 3456
#define XB_SPIN_CAP (1u << 18)

__device__ __forceinline__ unsigned xb_ld(unsigned* p)              { return __hip_atomic_load(p, __ATOMIC_RELAXED, __HIP_MEMORY_SCOPE_AGENT); }
__device__ __forceinline__ unsigned xb_add(unsigned* p, unsigned v) { return __hip_atomic_fetch_add(p, v, __ATOMIC_RELAXED, __HIP_MEMORY_SCOPE_AGENT); }
__device__ __forceinline__ unsigned xb_xcc_id() { return (unsigned)__builtin_amdgcn_s_getreg((3 << 11) | 20) & 0xFu; }
#define XB_SPIN(cond, bar) do { unsigned _sp = 0; while (cond) { __builtin_amdgcn_s_sleep(1); \
    if ((++_sp & 255u) == 0u) { if (xb_ld(&(bar)[XB_TMO])) break; if (_sp > XB_SPIN_CAP) { atomicAdd(&(bar)[XB_TMO], 1u); break; } } } } while (0)

struct XcdBarrier {
    unsigned* bar; unsigned x;
    volatile LAS unsigned* st;
};

__device__ __forceinline__ XcdBarrier xcd_barrier_post(unsigned* bar, volatile LAS unsigned* st) {
    XcdBarrier b; b.bar = bar; b.x = xb_xcc_id(); b.st = st;
    if (threadIdx.x == 0) (void)xb_add(&bar[XB_XCNT(b.x)], 1u);
    return b;
}
__device__ __forceinline__ void xcd_barrier_complete(unsigned* bar, unsigned x, unsigned& nloc, unsigned& nx) {
    const unsigned G = gridDim.x * gridDim.y * gridDim.z;
    unsigned sum, cnt, mine, sp = 0u;
    for (;;) {
        sum = 0u; cnt = 0u; mine = 0u;
#pragma unroll
        for (unsigned j = 0; j < 16; ++j) { const unsigned c = xb_ld(&bar[XB_XCNT(j)]); sum += c; cnt += (c > 0u) ? 1u : 0u; mine = (j == x) ? c : mine; }
        if (sum == G) break;
        __builtin_amdgcn_s_sleep(1);
        if ((++sp & 255u) == 0u) { if (xb_ld(&bar[XB_TMO])) break; if (sp > XB_SPIN_CAP) { atomicAdd(&bar[XB_TMO], 1u); break; } }
    }
    nloc = mine > 0u ? mine : 1u; nx = cnt > 0u ? cnt : 1u;
}

__device__ __forceinline__ void xcd_barrier(const XcdBarrier& b) {
    asm volatile("s_waitcnt vmcnt(0)" ::: "memory");
    __syncthreads();
    if (threadIdx.x == 0) {
        unsigned* bar = b.bar;
        __builtin_amdgcn_s_waitcnt(0);
        unsigned nloc = b.st[0], nx = b.st[1];
        if (nloc == 0u) { xcd_barrier_complete(bar, b.x, nloc, nx); b.st[0] = nloc; b.st[1] = nx; }
        const unsigned old = xb_add(&bar[XB_XSUB(b.x)], 1u);
        const unsigned gen = old / nloc;
        if (old + 1u == (gen + 1u) * nloc) {
            __builtin_amdgcn_fence(__ATOMIC_RELEASE, "agent");
            asm volatile("s_waitcnt vmcnt(0)" ::: "memory");
            const unsigned og = xb_add(&bar[XB_TOP], 1u);
            const unsigned tg = og / nx;
            if (og + 1u == (tg + 1u) * nx) xb_add(&bar[XB_TOPGEN], 1u);
            else XB_SPIN(xb_ld(&bar[XB_TOPGEN]) == tg, bar);
            __builtin_amdgcn_fence(__ATOMIC_ACQUIRE, "agent");
            xb_add(&bar[XB_XGEN(b.x)], 1u);
            asm volatile("s_waitcnt vmcnt(0)" ::: "memory");
        } else {
            XB_SPIN(xb_ld(&bar[XB_XGEN(b.x)]) == gen, bar);
            __builtin_amdgcn_fence(__ATOMIC_ACQUIRE, "agent");
            asm volatile("s_waitcnt vmcnt(0)" ::: "memory");
        }
    }
    __syncthreads();
}

constexpr int NPHASE = 14;
__global__ void __launch_bounds__(NT, 2) hybrid_fwd(KP p) {
#define RELOAD_P() do { } while (0)
    extern __shared__ __attribute__((aligned(16))) unsigned char lds_raw[];
    LAS unsigned char* lds = (LAS unsigned char*)lds_raw;
    const int tid = threadIdx.x, lane = tid & 63, wid = __builtin_amdgcn_readfirstlane(tid >> 6);
    const int G = gridDim.x, c = blockIdx.x;
    unsigned char* ws = p.ws;
    const int lo = p.ph_lo, hi = p.ph_hi;
#ifndef PHMASK
#define PHMASK 0x7fff
#endif
#if MK_LAUNCHES == 1
#define IN(k) (((PHMASK >> (k)) & 1) != 0)
#else
#define IN(k) (((PHMASK >> (k)) & 1) && lo <= (k) && (k) < hi)
#endif
#ifndef DUPMASK
#define DUPMASK 0
#endif
#define REP(k) for (int rep_ = 0; rep_ < (((DUPMASK >> (k)) & 1) ? 2 : 1); ++rep_)
#if MK_LAUNCHES == 1
#define SEAM(k) do { if (IN(k) && IN((k) + 1)) xcd_barrier(xbar); } while (0)
#else
#define SEAM(k) do { } while (0)
#endif
    volatile LAS unsigned* xst = (volatile LAS unsigned*)(lds + LDS_BYTES - 64);
    if (tid < 2) xst[tid] = 0u;
    __syncthreads();
    XcdBarrier xbar; xbar.bar = (unsigned*)ws; xbar.x = 0; xbar.st = xst;
#if MK_LAUNCHES == 1
    xbar = xcd_barrier_post((unsigned*)ws, xst);
#endif
    if (hi < 0) cg::this_grid().sync();
    bf16* Win = (bf16*)(ws + WS_WIN);
    RELOAD_P();
    if (IN(0)) phase_prologue(p, lds, wid, lane, 0);
    SEAM(0);
    RELOAD_P();
    if (IN(1)) {
        pg8::Gemm g{(const bf16*)(ws + WS_XN), Win, M, 7424, D}; pg8::InOrder S; S.init(M, 7424, G, c);
        EpiIn E{EpiUV{(bf16*)(ws + WS_U), (bf16*)(ws + WS_G), (f32x2v*)(ws + WS_VST)}, EpiZXD{(bf16*)p.out, (bf16*)(ws + WS_XBC), (float*)(ws + WS_DT), p.in[I_DTB], p.out}, EpiG{(bf16*)(ws + WS_GABS), MP}};
        pg8::gemm_phase<EpiIn, pg8::InOrder, true, true>(lds, g, S, E);
    }
    SEAM(1);
    RELOAD_P();
    if (IN(2)) {
        if (c < 64) { ssd_unit<true, true>(p, lds, 2 + (c >> 2), 0, c & 3, tid, wid, lane);
            for (int u = c; u < 128; u += 64) gmlp_unit(p, lds, u >> 3, u & 7, tid, wid, lane); }
        else { for (int u = 128 + (c - 64); u < 144 * 8; u += G - 64) gmlp_unit(p, lds, u >> 3, u & 7, tid, wid, lane);
            phase_prologue(p, lds, wid, lane, 1, (c - 64) * 8 + wid, (G - 64) * 8); }
    }
    SEAM(2);
    RELOAD_P();
    if (IN(3)) { for (int u = c; u < 256; u += G) ssd_unit<false, false>(p, lds, u >> 7, (u >> 2) & 31, u & 3, tid, wid, lane); }
    SEAM(3);
    RELOAD_P();
    if (IN(4)) phase_scan(p, tid);
    SEAM(4);
    RELOAD_P();
    if (IN(5)) { for (int u = c; u < 256; u += G) ssd_unit<true, false>(p, lds, u >> 7, (u >> 2) & 31, u & 3, tid, wid, lane); }
    SEAM(5);
#pragma clang loop unroll(disable)
    for (int ph = 6; ph <= 13; ++ph) {
        RELOAD_P();
        if (IN(ph)) {
            if (ph == 9) phase_mgs(p, wid, lane);
            else if (ph == 11) phase_x1(p, wid, lane);
            else if (ph == 12) {
                pg8::Gemm g{(const bf16*)(ws + WS_X1N), (const bf16*)(ws + WS_WUP), M, FF, D}; pg8::StaticOrder S; S.init(M, FF, G, c);
                EpiUp E{(bf16*)(ws + WS_H)};
                pg8::gemm_phase<EpiUp, pg8::StaticOrder, true, true>(lds, g, S, E);
            } else {
                const bf16* A; const bf16* B; int K, log_ns, nk, gate = 0; EpiGen E; E.GAB = (const bf16*)(ws + WS_GAB); E.T = (const bf16*)(ws + WS_T); E.ST = (float*)(ws + WS_ST);
                if (ph == 6)       { A = (const bf16*)(ws + WS_XN); B = Win + (size_t)7424 * D;     K = D;    log_ns = 0; nk = 0; E.mode = 3; E.O = (bf16*)(ws + WS_GAB); E.SL = nullptr; E.kb_shift = 0; gate = 1; }
                else if (ph == 7)  { A = (const bf16*)(ws + WS_U);  B = (const bf16*)(ws + WS_WA);  K = D;    log_ns = 1; nk = 8; E.mode = 0; E.O = (bf16*)(ws + WS_T);  E.SL = (float*)(ws + WS_SLA); E.kb_shift = 10; }
                else if (ph == 8)  { A = (const bf16*)p.out;        B = (const bf16*)(ws + WS_WB);  K = 2048; log_ns = 2; nk = 8; E.mode = 1; E.O = (bf16*)(ws + WS_T);  E.SL = (float*)(ws + WS_SLB); E.kb_shift = 10; }
                else if (ph == 10) { A = (const bf16*)(ws + WS_T);  B = (const bf16*)(ws + WS_WO);  K = D;    log_ns = 2; nk = 4; E.mode = 2; E.O = (bf16*)(ws + WS_T2); E.SL = (float*)(ws + WS_ACO); E.kb_shift = 9; }
                else               { A = (const bf16*)(ws + WS_H);  B = (const bf16*)(ws + WS_WDN); K = FF;   log_ns = 3; nk = 8; E.mode = 2; E.O = (bf16*)(ws + WS_F);  E.SL = (float*)(ws + WS_ACF); E.kb_shift = 10; }
                pg8::Gemm g{A, B, M, D, K}; pg8::TailOrder S; S.init(log_ns, nk, G, c, gate, ph == 8 ? 32 : 0);
                pg8::gemm_phase<EpiGen, pg8::TailOrder, true, true>(lds, g, S, E);
            }
        }
        if (ph == 6 || ph == 7) __syncthreads();
        else if (IN(ph) && IN(ph + 1)) xcd_barrier(xbar);
    }
    RELOAD_P();
    if (IN(14)) phase_final(p, wid, lane);
#undef IN
#undef SEAM
#undef RELOAD_P
}

extern "C" void kernel_launch(void* const* d_in, const int* in_sizes, int n_in, void* d_out, int out_size, void* d_ws, size_t ws_size, hipStream_t stream) {
    static int grid = 0;
    if (grid == 0) {
        if (n_in != 24 || ws_size < WS_END) { fprintf(stderr, "kernel_launch: unexpected n_in %d / ws_size %zu\n", n_in, ws_size); grid = -1; return; }
        int dev = 0, cus = 0, per_cu = 0;
        hipGetDevice(&dev); hipDeviceGetAttribute(&cus, hipDeviceAttributeMultiprocessorCount, dev);
        hipFuncSetAttribute((const void*)hybrid_fwd, hipFuncAttributeMaxDynamicSharedMemorySize, LDS_BYTES);
        hipOccupancyMaxActiveBlocksPerMultiprocessor(&per_cu, (const void*)hybrid_fwd, NT, LDS_BYTES);
        (void)hipGetLastError();
        if (per_cu < 1) fprintf(stderr, "kernel_launch: occupancy query says %d blocks/CU\n", per_cu);
        grid = cus;
    }
    if (grid < 0) return;
    KP a{};
    for (int i = 0; i < 24; ++i) a.in[i] = (const float*)d_in[i];
    a.out = (float*)d_out; a.ws = (unsigned char*)d_ws;
#if MK_LAUNCHES == 1
    (void)hipMemsetAsync(d_ws, 0, 16384, stream);
    a.ph_lo = 0; a.ph_hi = NPHASE + 1;
    void* args[] = {&a};
    hipError_t e = hipLaunchCooperativeKernel((const void*)hybrid_fwd, dim3(grid), dim3(NT), args, LDS_BYTES, stream);
    if (e != hipSuccess) fprintf(stderr, "cooperative launch failed: %s (grid %d)\n", hipGetErrorString(e), grid);
#else
#ifndef LASTPH
#define LASTPH NPHASE
#endif
    for (int k = 0; k <= LASTPH; ++k) { a.ph_lo = k; a.ph_hi = k + 1; hipLaunchKernelGGL(hybrid_fwd, dim3(grid), dim3(NT), LDS_BYTES, stream, a); }
#endif
}
```

```cpp
#include <hip/hip_runtime.h>
#include <hip/hip_cooperative_groups.h>
#include <cstdio>
#include <cstdint>
namespace cg = cooperative_groups;
namespace pg8 {
#define PG8_LAS __attribute__((address_space(3)))
typedef unsigned short bf16_t;
typedef short bf16x8 __attribute__((ext_vector_type(8)));
typedef float f32x4 __attribute__((ext_vector_type(4)));
typedef unsigned u32x4 __attribute__((ext_vector_type(4)));
constexpr int BM = 256, BK = 64, HALF = 128, HTB = HALF * BK * 2  , STAGE_BYTES = 8 * HTB, NXCD = 8, WGM = 8;

__host__ __device__ __forceinline__ int lds_byte(int r, int c) { const int st = (r >> 4) * 2 + (c >> 5), rr = r & 15, cc = c & 31, ob = rr * 64 + cc * 2; return st * 1024 + (ob ^ (((ob >> 9) & 1) << 5)); }
__host__ __device__ __forceinline__ void stage_rc(int b, int& R, int& C) { const int st = b / 1024, sb = b % 1024, swz = sb ^ (((sb >> 9) & 1) << 5); R = (st >> 1) * 16 + swz / 64; C = (st & 1) * 32 + (swz % 64) / 2; }
__host__ __device__ __forceinline__ int perm32(int rho) { const int n = rho >> 4, i = rho & 15; return 8 * (i >> 2) + 4 * n + (i & 3); }

struct Unit { int pm, pn, kb, nk; };
struct Gemm { const bf16_t* A; const bf16_t* Bt; int M, N, K; };

struct StaticOrder {
    int nM, nN, nwg, G, c;
    __host__ __device__ void init(int M, int N, int G_, int c_) { nM = M / BM; nN = N / BM; nwg = nM * nN; G = G_; c = c_; }
    __host__ __device__ bool next(int i, Unit& u) const {
        const long L = (long)i * G + c; if (L >= nwg) return false;
        int wgid = (int)L; { const int q = nwg / NXCD, r = nwg % NXCD, xcd = wgid % NXCD, off = wgid / NXCD; wgid = (xcd < r ? xcd * (q + 1) : r * (q + 1) + (xcd - r) * q) + off; }
        const int nig = WGM * nN, gid = wgid / nig, fm = gid * WGM, gsz = (nM - fm) < WGM ? (nM - fm) : WGM;
        u.pm = fm + ((wgid % nig) % gsz); u.pn = (wgid % nig) / gsz; u.kb = 0; u.nk = 0; return true;
    }
    __device__ __forceinline__ void a_ready(const Unit&) const {}
    __device__ __forceinline__ void done(const Unit&) const {}
};
struct InOrder {
    StaticOrder so; int np, G, cx;
    __host__ __device__ void init(int M, int N, int G_, int c_) { so.init(M, N, G_, c_); np = c_ < so.nwg ? (so.nwg - c_ + G_ - 1) / G_ : 0; G = G_; cx = (c_ - (so.nwg % G_) + G_) % G_; }
    __host__ __device__ bool next(int i, Unit& u) const {
        if (i < np) return so.next(i, u);
        const int l = (i - np) * G + cx; if (l >= 32) return false;
        u.pm = 64 + (l >> 3); u.pn = 29 + (l & 7); u.kb = 0; u.nk = 0; return true;
    }
    __device__ __forceinline__ void a_ready(const Unit&) const {}
    __device__ __forceinline__ void done(const Unit&) const {}
};
struct TailOrder {
    StaticOrder so; int np, n, G, c, log_ns, nk, gate, cx;
    __host__ __device__ void init(int log_ns_, int nk_, int G_, int c_, int gate_ = 0, int coff = 0) { cx = (c_ - coff % G_ + G_) % G_; so.init(64 * BM, 4 * BM, G_, c_); np = c_ < so.nwg ? (so.nwg - c_ + G_ - 1) / G_ : 0; log_ns = log_ns_; nk = nk_; n = gate_ ? 0 : (16 << log_ns_); G = G_; c = c_; gate = gate_; if (gate_) np *= 2; }
    __host__ __device__ bool next(int i, Unit& u) const {
        if (i < np) { if (!gate) return so.next(i, u); const bool ok = so.next(i >> 1, u); u.pn += 4 * (i & 1); return ok; }
        const int l = (i - np) * G + cx; if (l >= n) return false;
        u.kb = (l & ((1 << log_ns) - 1)) * (nk * BK * 2); u.nk = nk; const int t = l >> log_ns; u.pn = t & 3; u.pm = 64 + (t >> 2); return true;
    }
    __device__ __forceinline__ void a_ready(const Unit&) const {}
    __device__ __forceinline__ void done(const Unit&) const {}
};

__device__ __forceinline__ unsigned cvt_pk_bf16(float lo, float hi) { unsigned r; asm volatile("v_cvt_pk_bf16_f32 %0, %1, %2" : "=v"(r) : "v"(lo), "v"(hi)); return r; }
typedef float f32x2 __attribute__((ext_vector_type(2)));
template <class Epi, class Sched, bool ALIGN_EPI = false, bool SP2 = false>
__device__ __forceinline__ void gemm_phase(PG8_LAS unsigned char* lds, const Gemm g, const Sched& S, const Epi& E) {
    int tid_ = threadIdx.x; asm volatile("" : "+v"(tid_));
    const int tid = tid_, wid = __builtin_amdgcn_readfirstlane(tid >> 6), lane = tid & 63, wr = wid >> 2, wc = wid & 3, fr = lane & 15, fq = lane >> 4;
    const int K = g.K, ntfull = K / BK;
    unsigned voffA[2], voffB[2];
#pragma unroll
    for (int i = 0; i < 2; ++i) { int R, C; stage_rc(tid * 16 + i * 8192, R, C); const int Rb = Epi::PERM ? ((R & ~31) + perm32(R & 31)) : R;
        voffA[i] = (unsigned)(R * K + C) * 2u; voffB[i] = (unsigned)(Rb * K + C) * 2u; }
    const size_t kstep = (size_t)(BK * 2);
    const size_t hstep = (size_t)HALF * K * 2;
    const size_t tstep = 2 * hstep;
    const unsigned ldsw = (unsigned)wid * 1024u;
    const int aoff = lds_byte(wr * 64 + fr, fq * 8), boff = lds_byte(wc * 32 + fr, fq * 8);
#define PG8_SA(b, h) (((b) * 2 + (h)) * HTB)
#define PG8_SB(b, h) ((4 + (b) * 2 + (h)) * HTB)
#define PG8_STAGE(bufoff, gbase, voff) do { _Pragma("unroll") for (int _i = 0; _i < 2; ++_i) \
        __builtin_amdgcn_global_load_lds((const unsigned*)((const char*)(gbase) + (voff)[_i]), (PG8_LAS unsigned*)(lds + (bufoff) + ldsw + _i * 8192), 16, 0, 0); } while (0)
#define PG8_LDA(dst, b, h) do { _Pragma("unroll") for (int m = 0; m < 4; ++m) _Pragma("unroll") for (int k = 0; k < 2; ++k) dst[m][k] = *(const PG8_LAS bf16x8*)(lds + PG8_SA(b, h) + aoff + m * 2048 + k * 1024); } while (0)
#define PG8_LDB(dst, b, h) do { _Pragma("unroll") for (int n = 0; n < 2; ++n) _Pragma("unroll") for (int k = 0; k < 2; ++k) dst[n][k] = *(const PG8_LAS bf16x8*)(lds + PG8_SB(b, h) + boff + n * 2048 + k * 1024); } while (0)
#define PG8_MMA(ai, bj, At, Bt) do { __builtin_amdgcn_s_setprio(1); _Pragma("unroll") for (int m = 0; m < 4; ++m) _Pragma("unroll") for (int n = 0; n < 2; ++n) _Pragma("unroll") for (int k = 0; k < 2; ++k) \
        acc[ai][bj][m][n] = __builtin_amdgcn_mfma_f32_16x16x32_bf16(Bt[n][k], At[m][k], acc[ai][bj][m][n], 0, 0, 0); __builtin_amdgcn_s_setprio(0); } while (0)
#define PG8_WAIT_V(n) asm volatile("s_waitcnt vmcnt(" #n ")" ::: "memory")
#define PG8_WAIT_L(n) asm volatile("s_waitcnt lgkmcnt(" #n ")" ::: "memory")
#define PG8_BAR __builtin_amdgcn_s_barrier()
#define PG8_SCHED __builtin_amdgcn_sched_barrier(0)
    Unit cur, nxt; int ui = 0;
    if (!S.next(0, cur)) return;
    f32x4 acc[2][2][4][2];
#pragma unroll
    for (int a = 0; a < 2; ++a)
#pragma unroll
        for (int b = 0; b < 2; ++b)
#pragma unroll
            for (int m = 0; m < 4; ++m)
#pragma unroll
                for (int n = 0; n < 2; ++n) acc[a][b][m][n] = (f32x4){0.f, 0.f, 0.f, 0.f};
    bf16x8 At[4][2], B0[2][2], B1[2][2];
    const char* cA = (const char*)g.A + (size_t)cur.pm * tstep + cur.kb; const char* cB = (const char*)g.Bt + (size_t)cur.pn * tstep + cur.kb;
    S.a_ready(cur);
    if constexpr (SP2) {
        PG8_STAGE(PG8_SB(0, 0), cB, voffB); PG8_STAGE(PG8_SB(0, 1), cB + hstep, voffB); PG8_STAGE(PG8_SA(0, 0), cA, voffA); PG8_STAGE(PG8_SA(0, 1), cA + hstep, voffA);
        if (wr == 1) PG8_BAR;
        PG8_WAIT_V(2); PG8_BAR;
        PG8_STAGE(PG8_SB(1, 0), cB + kstep, voffB); PG8_STAGE(PG8_SA(1, 0), cA + kstep, voffA); PG8_STAGE(PG8_SB(1, 1), cB + hstep + kstep, voffB);
        PG8_WAIT_V(6); PG8_BAR;
    } else {
        PG8_STAGE(PG8_SB(0, 0), cB, voffB); PG8_STAGE(PG8_SA(0, 0), cA, voffA); PG8_STAGE(PG8_SB(0, 1), cB + hstep, voffB); PG8_STAGE(PG8_SA(0, 1), cA + hstep, voffA);
        if (wr == 1) PG8_BAR;
        PG8_WAIT_V(4); PG8_BAR;
        PG8_STAGE(PG8_SB(1, 0), cB + kstep, voffB); PG8_STAGE(PG8_SA(1, 0), cA + kstep, voffA); PG8_STAGE(PG8_SB(1, 1), cB + hstep + kstep, voffB);
        PG8_WAIT_V(6); PG8_BAR;
    }
    for (;;) {
        const bool has_next = S.next(ui + 1, nxt);
        const char* nA = has_next ? (const char*)g.A + (size_t)nxt.pm * tstep + nxt.kb : cA; const char* nB = has_next ? (const char*)g.Bt + (size_t)nxt.pn * tstep + nxt.kb : cB;
        const int nt = cur.nk ? cur.nk : ntfull;
        for (int t = 0; t < nt; t += 2) {
            const bool last = (t == nt - 2);
            const char* a1 = cA + (size_t)(t + 1) * kstep;
            const char* a2 = last ? nA : cA + (size_t)(t + 2) * kstep; const char* b2 = last ? nB : cB + (size_t)(t + 2) * kstep;
            const char* a3 = a2 + kstep; const char* b3 = b2 + kstep;
            if (last && has_next) S.a_ready(nxt);
            if constexpr (SP2) {
            PG8_LDB(B0, 0, 0); PG8_LDB(B1, 0, 1); PG8_SCHED; PG8_LDA(At, 0, 0); PG8_STAGE(PG8_SA(1, 1), a1 + hstep, voffA);
            PG8_WAIT_V(8); PG8_WAIT_L(0); PG8_BAR; PG8_MMA(0, 0, At, B0); PG8_MMA(0, 1, At, B1); PG8_BAR; PG8_SCHED;
            PG8_LDA(At, 0, 1); PG8_STAGE(PG8_SB(0, 0), b2, voffB); PG8_STAGE(PG8_SB(0, 1), b2 + hstep, voffB); PG8_STAGE(PG8_SA(0, 0), a2, voffA);
            PG8_WAIT_V(8); PG8_WAIT_L(0); PG8_BAR; PG8_MMA(1, 0, At, B0); PG8_MMA(1, 1, At, B1); PG8_BAR; PG8_SCHED;
            PG8_LDB(B0, 1, 0); PG8_LDB(B1, 1, 1); PG8_SCHED; PG8_LDA(At, 1, 0); PG8_STAGE(PG8_SA(0, 1), a2 + hstep, voffA);
            PG8_WAIT_V(8); PG8_WAIT_L(0); PG8_BAR; PG8_MMA(0, 0, At, B0); PG8_MMA(0, 1, At, B1); PG8_BAR; PG8_SCHED;
            PG8_LDA(At, 1, 1); PG8_STAGE(PG8_SB(1, 0), b3, voffB); PG8_STAGE(PG8_SB(1, 1), b3 + hstep, voffB); PG8_STAGE(PG8_SA(1, 0), a3, voffA);
            PG8_WAIT_V(8); PG8_WAIT_L(0); PG8_BAR; PG8_MMA(1, 0, At, B0); PG8_MMA(1, 1, At, B1); PG8_BAR; PG8_SCHED;
            } else {
            PG8_LDB(B0, 0, 0); PG8_SCHED; PG8_LDA(At, 0, 0); PG8_STAGE(PG8_SA(1, 1), a1 + hstep, voffA);
            PG8_WAIT_L(8); PG8_BAR; PG8_WAIT_L(0); PG8_MMA(0, 0, At, B0); PG8_BAR; PG8_SCHED;
            PG8_LDB(B1, 0, 1); PG8_STAGE(PG8_SB(0, 0), b2, voffB);
            PG8_BAR; PG8_WAIT_L(0); PG8_MMA(0, 1, At, B1); PG8_BAR;
            PG8_LDA(At, 0, 1); PG8_STAGE(PG8_SA(0, 0), a2, voffA);
            PG8_BAR; PG8_WAIT_L(0); PG8_MMA(1, 0, At, B0); PG8_BAR; PG8_SCHED;
            PG8_STAGE(PG8_SB(0, 1), b2 + hstep, voffB);
            PG8_WAIT_V(6); PG8_BAR; PG8_MMA(1, 1, At, B1); PG8_BAR;
            PG8_LDB(B0, 1, 0); PG8_SCHED; PG8_LDA(At, 1, 0); PG8_STAGE(PG8_SA(0, 1), a2 + hstep, voffA);
            PG8_WAIT_L(8); PG8_BAR; PG8_WAIT_L(0); PG8_MMA(0, 0, At, B0); PG8_BAR; PG8_SCHED;
            PG8_LDB(B1, 1, 1); PG8_STAGE(PG8_SB(1, 0), b3, voffB);
            PG8_BAR; PG8_WAIT_L(0); PG8_MMA(0, 1, At, B1); PG8_BAR;
            PG8_LDA(At, 1, 1); PG8_STAGE(PG8_SA(1, 0), a3, voffA);
            PG8_BAR; PG8_WAIT_L(0); PG8_MMA(1, 0, At, B0); PG8_BAR; PG8_SCHED;
            PG8_STAGE(PG8_SB(1, 1), b3 + hstep, voffB);
            PG8_WAIT_V(6); PG8_BAR; PG8_MMA(1, 1, At, B1); PG8_BAR;
            }
        }
        if constexpr (ALIGN_EPI) { if (wr == 0) PG8_BAR; }
        if constexpr (!Epi::AFTER_DRAIN) { E(acc, cur, wr, wc, fr, fq); S.done(cur); }
        if (!has_next) break;
#pragma unroll
        for (int a = 0; a < 2; ++a)
#pragma unroll
            for (int b = 0; b < 2; ++b)
#pragma unroll
                for (int m = 0; m < 4; ++m)
#pragma unroll
                    for (int n = 0; n < 2; ++n) acc[a][b][m][n] = (f32x4){0.f, 0.f, 0.f, 0.f};
        cur = nxt; cA = nA; cB = nB; ++ui;
        if constexpr (ALIGN_EPI) { if (wr == 1) PG8_BAR; }
    }
    PG8_WAIT_V(0);
    if constexpr (!ALIGN_EPI) { if (wr == 0) PG8_BAR; }
    PG8_BAR;
    if constexpr (Epi::AFTER_DRAIN) { E.fused(acc, cur, wr, wc, fr, fq, lds, wid, lane); S.done(cur); }
#undef PG8_SA
#undef PG8_SB
#undef PG8_STAGE
#undef PG8_LDA
#undef PG8_LDB
#undef PG8_MMA
#undef PG8_WAIT_V
#undef PG8_WAIT_L
#undef PG8_BAR
#undef PG8_SCHED
}
}

#ifndef MK_LAUNCHES
#define MK_LAUNCHES 1
#endif
#define LAS __attribute__((address_space(3)))
typedef unsigned short bf16;
using pg8::bf16x8; using pg8::f32x4; using pg8::u32x4; using pg8::Unit;
typedef __bf16 bf16x2_t __attribute__((ext_vector_type(2)));
typedef float f32x2_t __attribute__((ext_vector_type(2)));
__device__ __forceinline__ unsigned cvt_pk_bf16(float lo, float hi) { const f32x2_t f = {lo, hi}; const bf16x2_t b = __builtin_convertvector(f, bf16x2_t); return __builtin_bit_cast(unsigned, b); }
typedef unsigned u32x2 __attribute__((ext_vector_type(2)));
typedef float f32x2v __attribute__((ext_vector_type(2)));

constexpr int NT = 512;
constexpr int D = 1024, MP = 16384, MS = 1024, M = MP + MS, FF = 4096;
constexpr int NIN = 9248;
constexpr float EPS = 1e-6f;
constexpr int LDS_BYTES = 147456;
constexpr size_t O_CP = 17825792, O_SP = 17844224, O_CS = 18368512, O_SS = 18515968, O_VS = 22710272;
constexpr size_t HM = 512 * 1024;
constexpr size_t SH = 1032192;
constexpr size_t WS_WIN = 2 * HM - SH, WS_WA = 39 * HM - SH, WS_WB = 43 * HM - SH, WS_WO = 51 * HM - SH, WS_WUP = 55 * HM - SH, WS_WDN = 71 * HM - SH;
constexpr size_t WS_XN = 87 * HM - SH, WS_U = 155 * HM - SH, WS_G = 223 * HM - SH, WS_XBC = 291 * HM - SH;
constexpr size_t WS_VST = 495 * HM - SH, WS_DT = WS_VST + 2228224, WS_CD = WS_DT + 2228224, WS_ST = WS_CD + 8192, WS_ST2 = WS_ST  , WS_END = 512 * HM;
constexpr size_t WS_GABS = 504 * HM;
static_assert(WS_ST + 1114112 <= WS_GABS && WS_WIN == 16384, "tail of the d_ws map");
constexpr size_t WS_S = WS_G, WS_GAB = 223 * HM - SH, WS_T = 359 * HM - SH, WS_MG = WS_XN, WS_T2 = 223 * HM - SH, WS_X1N = 359 * HM - SH, WS_H = 87 * HM - SH, WS_F = 359 * HM - SH;
constexpr size_t WS_SLA = 427 * HM - SH, WS_SLB = 443 * HM - SH;
constexpr size_t WS_ACO = 427 * HM - SH, WS_ACF = 423 * HM - SH;

struct KP { const float* in[24]; float* out; unsigned char* ws; int ph_lo, ph_hi; };
enum { I_XP = 0, I_XS, I_CACHE, I_STATE, I_PREMIX, I_WIN, I_LNW, I_LNB, I_GWS, I_GBS, I_CONVW, I_CONVB, I_DTB, I_ALOG, I_DSKIP, I_SNW, I_WA, I_WB, I_WO, I_POSTMIX, I_PREFFN, I_WUP, I_WDN, I_POSTFFN };

__device__ __forceinline__ float bflo(unsigned w) { return __uint_as_float(w << 16); }
__device__ __forceinline__ float bfhi(unsigned w) { return __uint_as_float(w & 0xffff0000u); }
__device__ __forceinline__ float bf1(unsigned short b) { return __uint_as_float((unsigned)b << 16); }
__device__ __forceinline__ float fsigmoid(float x) { return __builtin_amdgcn_rcpf(1.f + __expf(-x)); }
__device__ __forceinline__ float fsilu(float x) { return x * fsigmoid(x); }
__device__ __forceinline__ float fgelu(float x) { const float t = x * (1.5957691216f + 0.0713548163f * x * x); return x * __builtin_amdgcn_rcpf(1.f + __expf(-t)); }
__device__ __forceinline__ float wave_sum(float v) {
#pragma unroll
    for (int o = 1; o < 64; o <<= 1) v += __shfl_xor(v, o);
    return v;
}
__device__ __forceinline__ u32x4 pack8(const float (&a)[8]) { u32x4 w; w.x = cvt_pk_bf16(a[0], a[1]); w.y = cvt_pk_bf16(a[2], a[3]); w.z = cvt_pk_bf16(a[4], a[5]); w.w = cvt_pk_bf16(a[6], a[7]); return w; }
__device__ __forceinline__ void unpack8(const u32x4 w, float (&a)[8]) { a[0] = bflo(w.x); a[1] = bfhi(w.x); a[2] = bflo(w.y); a[3] = bfhi(w.y); a[4] = bflo(w.z); a[5] = bfhi(w.z); a[6] = bflo(w.w); a[7] = bfhi(w.w); }
__device__ __forceinline__ const float* xrow(const KP& p, int m) { return m < MP ? p.in[I_XP] + (size_t)m * D : p.in[I_XS] + (size_t)(m - MP) * D; }

#define EPI_ROWS_BEGIN _Pragma("unroll") for (int ai = 0; ai < 2; ++ai) _Pragma("unroll") for (int m = 0; m < 4; ++m) { const int row = u.pm * 256 + ai * 128 + wr * 64 + m * 16 + fr;
#define EPI_COLS_BEGIN _Pragma("unroll") for (int bj = 0; bj < 2; ++bj) { const int col = u.pn * 256 + bj * 128 + wc * 32 + 8 * fq; \
        float v[8]; { const f32x4 v0 = acc[ai][bj][m][0], v1 = acc[ai][bj][m][1]; v[0] = v0[0]; v[1] = v0[1]; v[2] = v0[2]; v[3] = v0[3]; v[4] = v1[0]; v[5] = v1[1]; v[6] = v1[2]; v[7] = v1[3]; }
#define EPI_END }
typedef const f32x4 (&AccRef)[2][2][4][2];

struct EpiUV {
    static constexpr bool PERM = true, AFTER_DRAIN = false; bf16* U; bf16* G; f32x2v* VST;
    __device__ __forceinline__ void operator()(AccRef acc, const Unit& u, int wr, int wc, int fr, int fq) const {
        const bool isv = u.pn >= 4; bf16* base = isv ? G : U;
        EPI_ROWS_BEGIN float s = 0.f, s2 = 0.f;
            EPI_COLS_BEGIN
#pragma unroll
                for (int e = 0; e < 8; ++e) { v[e] = fgelu(v[e]); s += v[e]; s2 += v[e] * v[e]; }
                *(u32x4*)(base + (size_t)row * 1024 + (col & 1023)) = pack8(v);
            EPI_END
            if (isv) { s += __shfl_xor(s, 16); s += __shfl_xor(s, 32); s2 += __shfl_xor(s2, 16); s2 += __shfl_xor(s2, 32);
                if (fq == 0) VST[(size_t)row * 16 + (u.pn - 4) * 4 + wc] = (f32x2v){s, s2}; }
        EPI_END
    }
};
struct EpiZXD {
    static constexpr bool PERM = true, AFTER_DRAIN = false; bf16* Z; bf16* XBC; float* DT; const float* dtb; float* out;
    __device__ __forceinline__ void operator()(AccRef acc, const Unit& u, int wr, int wc, int fr, int fq) const {
        EPI_ROWS_BEGIN
            EPI_COLS_BEGIN
                if (u.pn < 8) {
#pragma unroll
                    for (int e = 0; e < 8; ++e) v[e] = fsilu(v[e]);
                    __builtin_nontemporal_store(pack8(v), (u32x4*)(Z + (size_t)row * 2048 + col));
                } else if (u.pn < 20) {
                    const int c = col - 2048;
                    *(u32x4*)(XBC + (size_t)row * 3072 + c) = pack8(v);
                    int k; size_t o;
                    if (row < MP) { k = (row & 8191) - 8189; o = O_CP + ((size_t)(row >> 13) * 3 + k) * 3072 + c; }
                    else { k = ((row - MP) & 63) - 61; o = O_CS + ((size_t)((row - MP) >> 6) * 3 + k) * 3072 + c; }
                    if (k >= 0) { *(f32x4*)(out + o) = (f32x4){v[0], v[1], v[2], v[3]}; *(f32x4*)(out + o + 4) = (f32x4){v[4], v[5], v[6], v[7]}; }
                } else if (bj == 0 && wc == 0) {
                    int c = 8 * fq; asm volatile("" : "+v"(c));
#pragma unroll
                    for (int e = 0; e < 8; ++e) { const float x = v[e] + dtb[c + e]; v[e] = x > 15.f ? x : log1pf(__expf(x)); }
                    *(f32x4*)(DT + (size_t)row * 32 + c) = (f32x4){v[0], v[1], v[2], v[3]}; *(f32x4*)(DT + (size_t)row * 32 + c + 4) = (f32x4){v[4], v[5], v[6], v[7]};
                }
            EPI_END
        EPI_END
    }
};
struct EpiG {
    static constexpr bool PERM = true, AFTER_DRAIN = false; bf16* GAB; int roff;
    __device__ __forceinline__ void operator()(AccRef acc, const Unit& u, int wr, int wc, int fr, int fq) const {
        EPI_ROWS_BEGIN EPI_COLS_BEGIN
#pragma unroll
            for (int e = 0; e < 8; ++e) v[e] = fsigmoid(v[e]);
            *(u32x4*)(GAB + (size_t)(row - roff) * 2048 + col) = pack8(v);
        EPI_END EPI_END
    }
};
struct EpiIn {
    static constexpr bool PERM = true, AFTER_DRAIN = false; EpiUV uv; EpiZXD zxd; EpiG gs;
    __device__ __forceinline__ void operator()(AccRef acc, const Unit& u, int wr, int wc, int fr, int fq) const {
        if (u.pn < 8) uv(acc, u, wr, wc, fr, fq);
        else if (u.pn < 29) { Unit v = u; v.pn = u.pn - 8; zxd(acc, v, wr, wc, fr, fq); }
        else { Unit v = u; v.pn = u.pn - 29; gs(acc, v, wr, wc, fr, fq); }
    }
};
struct EpiA {
    static constexpr bool PERM = true, AFTER_DRAIN = false; const bf16* GAB; const bf16* GABS; bf16* T;
    __device__ __forceinline__ void operator()(AccRef acc, const Unit& u, int wr, int wc, int fr, int fq) const {
        EPI_ROWS_BEGIN EPI_COLS_BEGIN
            float s[8]; unpack8(*(const u32x4*)((row < MP ? GAB + (size_t)row * 2048 : GABS + (size_t)(row - MP) * 2048) + col), s);
#pragma unroll
            for (int e = 0; e < 8; ++e) v[e] *= s[e];
            *(u32x4*)(T + (size_t)row * 1024 + col) = pack8(v);
        EPI_END EPI_END
    }
};
struct EpiB {
    static constexpr bool PERM = true, AFTER_DRAIN = false; const bf16* GAB; const bf16* GABS; const bf16* T; bf16* MG;
    __device__ __forceinline__ void operator()(AccRef acc, const Unit& u, int wr, int wc, int fr, int fq) const {
        EPI_ROWS_BEGIN EPI_COLS_BEGIN
            float s[8], t[8]; unpack8(*(const u32x4*)((row < MP ? GAB + (size_t)row * 2048 : GABS + (size_t)(row - MP) * 2048) + 1024 + col), s); unpack8(*(const u32x4*)(T + (size_t)row * 1024 + col), t);
#pragma unroll
            for (int e = 0; e < 8; ++e) v[e] = t[e] + s[e] * v[e];
            *(u32x4*)(MG + (size_t)row * 1024 + col) = pack8(v);
        EPI_END EPI_END
    }
};

struct EpiSq {
    static constexpr bool PERM = true, AFTER_DRAIN = false; bf16* O; float* ST;
    __device__ __forceinline__ void operator()(AccRef acc, const Unit& u, int wr, int wc, int fr, int fq) const {
        EPI_ROWS_BEGIN float s2 = 0.f;
            EPI_COLS_BEGIN
#pragma unroll
                for (int e = 0; e < 8; ++e) s2 += v[e] * v[e];
                *(u32x4*)(O + (size_t)row * 1024 + col) = pack8(v);
            EPI_END
            s2 += __shfl_xor(s2, 16); s2 += __shfl_xor(s2, 32);
            if (fq == 0) ST[(size_t)row * 16 + u.pn * 4 + wc] = s2;
        EPI_END
    }
};
struct EpiSqTail {
    static constexpr bool PERM = true, AFTER_DRAIN = false; EpiSq sq; float* SL; int kb_shift;
    __device__ __forceinline__ void operator()(AccRef acc, const Unit& u, int wr, int wc, int fr, int fq) const {
        if (u.nk == 0) { sq(acc, u, wr, wc, fr, fq); return; }
        float* base = SL + (size_t)(u.kb >> kb_shift) * (MS * D);
        EPI_ROWS_BEGIN EPI_COLS_BEGIN
            float* t = base + (size_t)(row - MP) * 1024 + col;
            *(f32x4*)t = (f32x4){v[0], v[1], v[2], v[3]}; *(f32x4*)(t + 4) = (f32x4){v[4], v[5], v[6], v[7]};
        EPI_END EPI_END
    }
};
struct EpiGen {
    static constexpr bool PERM = true, AFTER_DRAIN = false; int mode; const bf16* GAB; const bf16* T; bf16* O; float* ST; float* SL; int kb_shift;
    __device__ __forceinline__ void operator()(AccRef acc, const Unit& u, int wr, int wc, int fr, int fq) const {
        if (u.nk != 0) {
            float* base = SL + (size_t)(u.kb >> kb_shift) * (MS * D);
            EPI_ROWS_BEGIN EPI_COLS_BEGIN
                float* t = base + (size_t)(row - MP) * 1024 + col;
                *(f32x4*)t = (f32x4){v[0], v[1], v[2], v[3]}; *(f32x4*)(t + 4) = (f32x4){v[4], v[5], v[6], v[7]};
            EPI_END EPI_END
            return;
        }
        if (mode == 2) {
            EPI_ROWS_BEGIN float s2 = 0.f;
                EPI_COLS_BEGIN
#pragma unroll
                    for (int e = 0; e < 8; ++e) s2 += v[e] * v[e];
                    *(u32x4*)(O + (size_t)row * 1024 + col) = pack8(v);
                EPI_END
                s2 += __shfl_xor(s2, 16); s2 += __shfl_xor(s2, 32);
                if (fq == 0) ST[(size_t)row * 16 + u.pn * 4 + wc] = s2;
            EPI_END
            return;
        }
        if (mode == 3) {
            EPI_ROWS_BEGIN EPI_COLS_BEGIN
#pragma unroll
                for (int e = 0; e < 8; ++e) v[e] = fsigmoid(v[e]);
                *(u32x4*)(O + (size_t)row * 2048 + col) = pack8(v);
            EPI_END EPI_END
            return;
        }
        const int goff = mode ? 1024 : 0;
        EPI_ROWS_BEGIN EPI_COLS_BEGIN
            float s[8]; unpack8(*(const u32x4*)(GAB + (size_t)row * 2048 + goff + col), s);
            if (mode) { float t[8]; unpack8(*(const u32x4*)(T + (size_t)row * 1024 + col), t);
#pragma unroll
                for (int e = 0; e < 8; ++e) v[e] = t[e] + s[e] * v[e]; }
            else {
#pragma unroll
                for (int e = 0; e < 8; ++e) v[e] *= s[e]; }
            *(u32x4*)(O + (size_t)row * 1024 + col) = pack8(v);
        EPI_END EPI_END
    }
};
struct EpiUp {
    static constexpr bool PERM = true, AFTER_DRAIN = false; bf16* H;
    __device__ __forceinline__ void operator()(AccRef acc, const Unit& u, int wr, int wc, int fr, int fq) const {
        EPI_ROWS_BEGIN EPI_COLS_BEGIN
#pragma unroll
            for (int e = 0; e < 8; ++e) { const float r = fmaxf(v[e], 0.f); v[e] = r * r; }
            *(u32x4*)(H + (size_t)row * FF + col) = pack8(v);
        EPI_END EPI_END
    }
};

__device__ __forceinline__ void tr_item(const float* W, int K, int N, bf16* WT, const float* scale, bool winmap, LAS float* scr, int item, int lane) {
    const int nblk = N / 32, kb = item / nblk, nb = item % nblk, k0 = 64 * kb, n0 = 32 * nb;
    float wv[32];
#pragma unroll
    for (int i = 0; i < 32; ++i) wv[i] = __builtin_nontemporal_load(W + (size_t)(k0 + 2 * i + (lane >> 5)) * N + n0 + (lane & 31));
#pragma unroll
    for (int i = 0; i < 32; ++i) { const int kk = 2 * i + (lane >> 5); float v = wv[i]; if (scale) v *= scale[k0 + kk]; scr[kk * 33 + (lane & 31)] = v; }
    asm volatile("s_waitcnt lgkmcnt(0)" ::: "memory");
    const int c = lane & 7; const int rbase = (winmap && n0 >= 7200) ? n0 + 224 : n0;
#pragma unroll
    for (int j = 0; j < 4; ++j) { const int n = (lane >> 3) + 8 * j; const LAS float* s = scr + (8 * c) * 33 + n;
        u32x4 o; o.x = cvt_pk_bf16(s[0 * 33], s[1 * 33]); o.y = cvt_pk_bf16(s[2 * 33], s[3 * 33]); o.z = cvt_pk_bf16(s[4 * 33], s[5 * 33]); o.w = cvt_pk_bf16(s[6 * 33], s[7 * 33]);
        u32x4* dst = (u32x4*)(WT + (size_t)(rbase + n) * K + k0 + 8 * c);
        if (winmap) *dst = o; else __builtin_nontemporal_store(o, dst); }
    asm volatile("s_waitcnt lgkmcnt(0)" ::: "memory");
}
__device__ __forceinline__ void phase_prologue(const KP& p, LAS unsigned char* lds, int wid, int lane, int part, int gw_ = -1, int ngw_ = 0) {
    LAS float* scr = (LAS float*)(lds + wid * 16384);
    const int gw = gw_ >= 0 ? gw_ : blockIdx.x * 8 + wid, NGW = gw_ >= 0 ? ngw_ : gridDim.x * 8;
    constexpr int I_IN = 16 * 289, I_A = 16 * 32, I_B = 32 * 32, I_O = 16 * 32, I_UP = 16 * 128, I_DN = 64 * 32;
    constexpr int NITEMS = I_IN + I_A + I_B + I_O + I_UP + I_DN;
    unsigned char* ws = p.ws;
#pragma clang loop unroll(disable)
    for (int it = (part ? I_IN : 0) + gw; it < (part ? NITEMS : I_IN); it += NGW) {
        int r = it; const float* W; int K, N; bf16* WT; const float* sc = nullptr; bool wm = false;
        if (r < I_IN) { W = p.in[I_WIN]; K = D; N = NIN; WT = (bf16*)(ws + WS_WIN); sc = p.in[I_PREMIX]; wm = true; }
        else if ((r -= I_IN) < I_A) { W = p.in[I_WA]; K = D; N = D; WT = (bf16*)(ws + WS_WA); }
        else if ((r -= I_A) < I_B) { W = p.in[I_WB]; K = 2048; N = D; WT = (bf16*)(ws + WS_WB); }
        else if ((r -= I_B) < I_O) { W = p.in[I_WO]; K = D; N = D; WT = (bf16*)(ws + WS_WO); }
        else if ((r -= I_O) < I_UP) { W = p.in[I_WUP]; K = D; N = FF; WT = (bf16*)(ws + WS_WUP); sc = p.in[I_PREFFN]; }
        else { r -= I_UP; W = p.in[I_WDN]; K = FF; N = D; WT = (bf16*)(ws + WS_WDN); }
        tr_item(W, K, N, WT, sc, wm, scr, r, lane);
    }
    if (part) return;
    bf16* XN = (bf16*)(ws + WS_XN);
    for (int m = gw; m < M; m += NGW) {
        const f32x4* xr = (const f32x4*)xrow(p, m) + lane; f32x4 v[4]; float s = 0.f;
#pragma unroll
        for (int j = 0; j < 4; ++j) { v[j] = __builtin_nontemporal_load(xr + 64 * j); s += (v[j][0] * v[j][0] + v[j][1] * v[j][1]) + (v[j][2] * v[j][2] + v[j][3] * v[j][3]); }
        const float r = rsqrtf(wave_sum(s) * (1.f / D) + EPS);
        u32x2* o = (u32x2*)(XN + (size_t)m * D) + lane;
#pragma unroll
        for (int j = 0; j < 4; ++j) { u32x2 w; w.x = cvt_pk_bf16(v[j][0] * r, v[j][1] * r); w.y = cvt_pk_bf16(v[j][2] * r, v[j][3] * r); o[64 * j] = w; }
    }
}

__device__ __forceinline__ void gmlp_unit(const KP& p, LAS unsigned char* lds, int ck, int g, int tid, int wid, int lane, bool dry = false) {
    LAS bf16* Wl = (LAS bf16*)lds;
    LAS bf16* Vt = (LAS bf16*)(lds + 34816);
    LAS f32x2v* RS = (LAS f32x2v*)(lds + 69632);
    const bool sample = ck >= 128; const int nrows = sample ? 64 : 128; const int row0 = sample ? MP + (ck - 128) * 64 : ck * 128;
    bf16* U = (bf16*)(p.ws + WS_U); const bf16* G = (const bf16*)(p.ws + WS_G); const f32x2v* VST = (const f32x2v*)(p.ws + WS_VST);
    const float* Wg = p.in[I_GWS] + (size_t)g * 16384;
#pragma unroll
    for (int it = 0; it < 8; ++it) { const int idx = tid + it * NT; const int i = idx >> 5, j4 = (idx & 31) * 4; const f32x4 w = *(const f32x4*)(Wg + i * 128 + j4);
        u32x2 o; o.x = cvt_pk_bf16(w[0], w[1]); o.y = cvt_pk_bf16(w[2], w[3]); *(LAS u32x2*)(Wl + i * 136 + j4) = o; }
    if (tid < nrows) { const f32x2v* s = VST + (size_t)(row0 + tid) * 16; float a = 0.f, b = 0.f;
#pragma unroll
        for (int t = 0; t < 16; ++t) { const f32x2v x = s[t]; a += x.x; b += x.y; }
        const float mean = a * (1.f / 1024.f); const float var = fmaxf(b * (1.f / 1024.f) - mean * mean, 0.f); RS[tid] = (f32x2v){mean, rsqrtf(var + EPS)}; }
    __syncthreads();
    for (int it = tid; it < nrows * 16; it += NT) { const int j = it >> 4, d8 = (it & 15) * 8; const int c = g * 128 + d8;
        float x[8]; unpack8(*(const u32x4*)(G + (size_t)(row0 + j) * 1024 + c), x);
        const f32x2v rs = RS[j]; const f32x4 w0 = *(const f32x4*)(p.in[I_LNW] + c), w1 = *(const f32x4*)(p.in[I_LNW] + c + 4), b0 = *(const f32x4*)(p.in[I_LNB] + c), b1 = *(const f32x4*)(p.in[I_LNB] + c + 4);
        const float lw[8] = {w0[0], w0[1], w0[2], w0[3], w1[0], w1[1], w1[2], w1[3]}, lb[8] = {b0[0], b0[1], b0[2], b0[3], b1[0], b1[1], b1[2], b1[3]};
#pragma unroll
        for (int e = 0; e < 8; ++e) { x[e] = (x[e] - rs.x) * rs.y * lw[e] + lb[e]; Vt[(d8 + e) * 136 + j] = (bf16)(cvt_pk_bf16(x[e], 0.f) & 0xffffu); }
        if (sample && !dry) { float* o = p.out + O_VS + ((size_t)(ck - 128) * 64 + j) * 1024 + c; *(f32x4*)o = (f32x4){x[0], x[1], x[2], x[3]}; *(f32x4*)(o + 4) = (f32x4){x[4], x[5], x[6], x[7]}; }
    }
    __syncthreads();
    const int fr = lane & 15, q = lane >> 4; const int ibl = wid >> 1, ds0 = (wid & 1) * 4;
    f32x4 alo[4], ahi[4];
#pragma unroll
    for (int d = 0; d < 4; ++d) { alo[d] = (f32x4){0.f, 0.f, 0.f, 0.f}; ahi[d] = (f32x4){0.f, 0.f, 0.f, 0.f}; }
#pragma unroll
    for (int ks = 0; ks < 4; ++ks) {
        if (ks >= 2 && sample) break;
        bf16x8 X[4];
#pragma unroll
        for (int d = 0; d < 4; ++d) X[d] = *(const LAS bf16x8*)(Vt + ((ds0 + d) * 16 + fr) * 136 + ks * 32 + 8 * q);
        if (ks < 2) { const bf16x8 Y = *(const LAS bf16x8*)(Wl + (ibl * 16 + fr) * 136 + ks * 32 + 8 * q);
#pragma unroll
            for (int d = 0; d < 4; ++d) alo[d] = __builtin_amdgcn_mfma_f32_16x16x32_bf16(X[d], Y, alo[d], 0, 0, 0); }
        if (!sample) { const bf16x8 Y = *(const LAS bf16x8*)(Wl + ((4 + ibl) * 16 + fr) * 136 + ks * 32 + 8 * q);
#pragma unroll
            for (int d = 0; d < 4; ++d) ahi[d] = __builtin_amdgcn_mfma_f32_16x16x32_bf16(X[d], Y, ahi[d], 0, 0, 0); }
    }
#pragma unroll
    for (int hh = 0; hh < 2; ++hh) {
        if (hh == 1 && sample) break;
        const int i = (hh * 4 + ibl) * 16 + fr; const float bsv = p.in[I_GBS][g * 128 + i];
#pragma unroll
        for (int d = 0; d < 4; ++d) { const f32x4 a = hh ? ahi[d] : alo[d]; bf16* up = U + (size_t)(row0 + i) * 1024 + g * 128 + (ds0 + d) * 16 + 4 * q;
            const u32x2 uu = *(const u32x2*)up; u32x2 o; o.x = cvt_pk_bf16(bflo(uu.x) * (a[0] + bsv), bfhi(uu.x) * (a[1] + bsv)); o.y = cvt_pk_bf16(bflo(uu.y) * (a[2] + bsv), bfhi(uu.y) * (a[3] + bsv));
            if (!dry) *(u32x2*)up = o; }
    }
    __syncthreads();
}

__device__ __forceinline__ u32x4 ssd_load8(const KP& p, const bf16* XBC, int seq, int rowbase, int trel, int ch) {
    if (trel >= 0) return *(const u32x4*)(XBC + (size_t)(rowbase + trel) * 3072 + ch);
    if (seq >= 2) { const float* h = p.in[I_CACHE] + ((size_t)(seq - 2) * 3 + (trel + 3)) * 3072 + ch; const f32x4 a = *(const f32x4*)h, b = *(const f32x4*)(h + 4);
        return (u32x4){cvt_pk_bf16(a[0], a[1]), cvt_pk_bf16(a[2], a[3]), cvt_pk_bf16(b[0], b[1]), cvt_pk_bf16(b[2], b[3])}; }
    return (u32x4){0u, 0u, 0u, 0u};
}
__device__ __forceinline__ u32x2 ld8_agent(const bf16* q) { const unsigned long long v = __hip_atomic_load((const unsigned long long*)q, __ATOMIC_RELAXED, __HIP_MEMORY_SCOPE_AGENT); return (u32x2){(unsigned)v, (unsigned)(v >> 32)}; }
__device__ __forceinline__ void st8_agent(bf16* q, u32x2 w) { __hip_atomic_store((unsigned long long*)q, ((unsigned long long)w.y << 32) | w.x, __ATOMIC_RELAXED, __HIP_MEMORY_SCOPE_AGENT); }
template <bool WITH_Y, bool SAMPLE>
__device__ __forceinline__ void ssd_unit(const KP& p, LAS unsigned char* lds, int seq, int sc, int g, int tid, int wid, int lane, bool dry = false) {
    LAS bf16* XT = (LAS bf16*)lds;
    LAS bf16* BT = (LAS bf16*)(lds + 73728);
    LAS bf16* Cs = (LAS bf16*)(lds + 92160);
    LAS bf16* Bs = (LAS bf16*)(lds + 109568);
    LAS float* CBs = (LAS float*)(lds + 109568);
    LAS float* ACUM = (LAS float*)(lds + 126976);
    LAS float* DTL = ACUM + 512;
    LAS float* NP = DTL + 512;
    constexpr bool sample = SAMPLE; const int rowbase = sample ? MP + (seq - 2) * 64 : seq * 8192; constexpr int nch = sample ? 1 : 4; const int c0 = sc * 4;
    const int h = g * 8 + wid; const float a_h = -__expf(p.in[I_ALOG][h]); const float Dh = p.in[I_DSKIP][h];
    const int fr = lane & 15, q = lane >> 4;
    const bf16* XBC = (const bf16*)(p.ws + WS_XBC); const float* DT = (const float*)(p.ws + WS_DT);
    bf16* Zb = (bf16*)p.out; bf16* Sb = (bf16*)(p.ws + WS_S); float* CD = (float*)(p.ws + WS_CD);
    const float* cw = p.in[I_CONVW]; const float* cb = p.in[I_CONVB];
    u32x4 hs[4][4];
#pragma unroll
    for (int pb = 0; pb < 4; ++pb)
#pragma unroll
        for (int t = 0; t < 4; ++t) hs[pb][t] = (u32x4){0u, 0u, 0u, 0u};
    bf16* Sent = Sb + ((size_t)(seq * 32 + sc) * 32 + h) * 8192 + (size_t)fr * 128 + 4 * q;
    const float* Hin = p.in[I_STATE] + ((size_t)((sample ? seq - 2 : 0) * 32 + h) * 64 + fr) * 128 + 4 * q;
    float lastsum = 0.f;
#pragma unroll 1
    for (int cc = 0; cc < nch; ++cc) {
        const int cidx = c0 + cc; const int r0 = rowbase + cidx * 64;
        bf16* zrow = Zb + (size_t)(r0 + fr) * 2048 + h * 64 + 4 * q; bf16* sentc = Sent;
        asm volatile("" : "+v"(zrow), "+v"(sentc));
        const float dtv = DT[(size_t)(r0 + lane) * 32 + h];
        const int chl = wid * 64 + (lane & 7) * 8, j0 = (lane >> 3) * 8; int ch = g * 512 + chl;
        const int oct2 = tid & 31, seg2 = tid >> 5; const bool isC = oct2 >= 16; const bool bc_on = WITH_Y || !isC;
        const int nl = (oct2 & 15) * 8, j02 = seg2 * 4; int ch2 = 2048 + (isC ? 512 : 0) + g * 128 + nl;
        asm volatile("" : "+v"(ch), "+v"(ch2));
        u32x4 rawx[11], rawb[7];
#pragma unroll
        for (int r = 0; r < 11; ++r) rawx[r] = ssd_load8(p, XBC, seq, rowbase, cidx * 64 + j0 - 3 + r, ch);
        if (bc_on) {
#pragma unroll
            for (int r = 0; r < 7; ++r) rawb[r] = ssd_load8(p, XBC, seq, rowbase, cidx * 64 + j02 - 3 + r, ch2); }
        float acum = dtv * a_h;
#pragma unroll
        for (int o = 1; o < 64; o <<= 1) { const float t = __shfl_up(acum, o); if (lane >= o) acum += t; }
        const float last = __shfl(acum, 63);
        ACUM[wid * 64 + lane] = acum; DTL[wid * 64 + lane] = dtv;
        {
#pragma unroll
            for (int hf = 0; hf < 2; ++hf) {
                const int c4 = ch + 4 * hf;
                const f32x4 w0 = *(const f32x4*)(cw + c4), w1 = *(const f32x4*)(cw + 3072 + c4), w2 = *(const f32x4*)(cw + 6144 + c4), w3 = *(const f32x4*)(cw + 9216 + c4), bb = *(const f32x4*)(cb + c4);
                f32x4 x0, x1, x2, prev; unsigned pk[4][4];
#pragma unroll
                for (int r = 0; r < 11; ++r) {
                    const u32x4 rw = rawx[r];
                    const unsigned ra = hf ? rw.z : rw.x, rb = hf ? rw.w : rw.y; const f32x4 cur = (f32x4){bflo(ra), bfhi(ra), bflo(rb), bfhi(rb)};
                    if (r >= 3) { f32x4 t = bb + w0 * x0 + w1 * x1 + w2 * x2 + w3 * cur;
#pragma unroll
                        for (int e = 0; e < 4; ++e) t[e] = fsilu(t[e]);
                        if ((r - 3) & 1) {
#pragma unroll
                            for (int e = 0; e < 4; ++e) pk[e][(r - 3) >> 1] = cvt_pk_bf16(prev[e], t[e]); }
                        else prev = t; }
                    x0 = x1; x1 = x2; x2 = cur;
                }
#pragma unroll
                for (int e = 0; e < 4; ++e) *(LAS u32x4*)(XT + (size_t)(chl + 4 * hf + e) * 72 + j0) = (u32x4){pk[e][0], pk[e][1], pk[e][2], pk[e][3]};
                asm volatile("" ::: "memory");
            }
        }
        if (bc_on) {
#pragma unroll
            for (int hf = 0; hf < 2; ++hf) {
                const int c4 = ch2 + 4 * hf;
                const f32x4 w0 = *(const f32x4*)(cw + c4), w1 = *(const f32x4*)(cw + 3072 + c4), w2 = *(const f32x4*)(cw + 6144 + c4), w3 = *(const f32x4*)(cw + 9216 + c4), bb = *(const f32x4*)(cb + c4);
                f32x4 x0, x1, x2, o[4];
#pragma unroll
                for (int r = 0; r < 7; ++r) {
                    const unsigned ra = hf ? rawb[r].z : rawb[r].x, rb = hf ? rawb[r].w : rawb[r].y; const f32x4 cur = (f32x4){bflo(ra), bfhi(ra), bflo(rb), bfhi(rb)};
                    if (r >= 3) { f32x4 t = bb + w0 * x0 + w1 * x1 + w2 * x2 + w3 * cur;
#pragma unroll
                        for (int e = 0; e < 4; ++e) t[e] = fsilu(t[e]);
                        o[r - 3] = t; }
                    x0 = x1; x1 = x2; x2 = cur;
                }
                if (WITH_Y) {
#pragma unroll
                    for (int jj = 0; jj < 4; ++jj) *(LAS u32x2*)((isC ? Cs : Bs) + (j02 + jj) * 136 + nl + 4 * hf) = (u32x2){cvt_pk_bf16(o[jj][0], o[jj][1]), cvt_pk_bf16(o[jj][2], o[jj][3])};
                }
                if (!isC) {
#pragma unroll
                    for (int e = 0; e < 4; ++e) *(LAS u32x2*)(BT + (nl + 4 * hf + e) * 72 + j02) = (u32x2){cvt_pk_bf16(o[0][e], o[1][e]), cvt_pk_bf16(o[2][e], o[3][e])};
                }
                asm volatile("" ::: "memory");
            }
        }
        __syncthreads();
        LAS bf16* XTh = XT + wid * 64 * 72;
        if (WITH_Y) {
            const int ibc = wid >> 1, jb0 = (wid & 1) * 2; f32x4 cbt[2];
#pragma unroll
            for (int jt = 0; jt < 2; ++jt) { cbt[jt] = (f32x4){0.f, 0.f, 0.f, 0.f}; const int jb = jb0 + jt;
                if (jb <= ibc) {
#pragma unroll
                    for (int ks = 0; ks < 4; ++ks) { const bf16x8 X = *(const LAS bf16x8*)(Bs + (jb * 16 + fr) * 136 + ks * 32 + 8 * q), Y = *(const LAS bf16x8*)(Cs + (ibc * 16 + fr) * 136 + ks * 32 + 8 * q);
                        cbt[jt] = __builtin_amdgcn_mfma_f32_16x16x32_bf16(X, Y, cbt[jt], 0, 0, 0); } } }
            __syncthreads();
#pragma unroll
            for (int jt = 0; jt < 2; ++jt) *(LAS f32x4*)(CBs + (ibc * 16 + fr) * 68 + (jb0 + jt) * 16 + 4 * q) = cbt[jt];
            __syncthreads();
            f32x4 ya[4][4];
#pragma unroll
            for (int pb = 0; pb < 4; ++pb)
#pragma unroll
                for (int ib = 0; ib < 4; ++ib) ya[pb][ib] = (f32x4){0.f, 0.f, 0.f, 0.f};
#ifndef NO_YOFF
#pragma unroll
            for (int t = 0; t < 4; ++t) {
                u32x4 hf4[4];
#pragma unroll
                for (int pb = 0; pb < 4; ++pb) {
                    if (sample) { const f32x4 a = *(const f32x4*)(Hin + pb * 2048 + 32 * t), b = *(const f32x4*)(Hin + pb * 2048 + 32 * t + 16); hf4[pb] = (u32x4){cvt_pk_bf16(a[0], a[1]), cvt_pk_bf16(a[2], a[3]), cvt_pk_bf16(b[0], b[1]), cvt_pk_bf16(b[2], b[3])}; }
                    else { const u32x2 a = *(const u32x2*)(sentc + pb * 2048 + 32 * t), b = *(const u32x2*)(sentc + pb * 2048 + 32 * t + 16); hf4[pb] = (u32x4){a.x, a.y, b.x, b.y}; } }
#pragma unroll
                for (int ib = 0; ib < 4; ++ib) { const u32x2 ca = *(const LAS u32x2*)(Cs + (ib * 16 + fr) * 136 + 32 * t + 4 * q), cb2 = *(const LAS u32x2*)(Cs + (ib * 16 + fr) * 136 + 32 * t + 16 + 4 * q);
                    const bf16x8 Y = __builtin_bit_cast(bf16x8, ((u32x4){ca.x, ca.y, cb2.x, cb2.y}));
#pragma unroll
                    for (int pb = 0; pb < 4; ++pb) ya[pb][ib] = __builtin_amdgcn_mfma_f32_16x16x32_bf16(__builtin_bit_cast(bf16x8, hf4[pb]), Y, ya[pb][ib], 0, 0, 0); }
                asm volatile("" ::: "memory"); }
#pragma unroll
            for (int ib = 0; ib < 4; ++ib) { const float ea = __expf(ACUM[wid * 64 + ib * 16 + fr]);
#pragma unroll
                for (int pb = 0; pb < 4; ++pb) ya[pb][ib] = ya[pb][ib] * ea; }
#endif
            u32x2 zz[4][4];
#pragma unroll
            for (int ib = 0; ib < 4; ++ib)
#pragma unroll
                for (int pb = 0; pb < 4; ++pb) zz[ib][pb] = *(const u32x2*)(zrow + ib * 32768 + pb * 16);
#ifndef NO_YDIAG
#pragma unroll
            for (int ib = 0; ib < 4; ++ib)
#pragma unroll
                for (int ks = 0; ks < 2; ++ks) {
                    if (ks == 1 && ib < 2) continue;
                    const int i = ib * 16 + fr, js0 = ks * 32 + 8 * q; const float ai = ACUM[wid * 64 + i];
                    const f32x4 c0v = *(const LAS f32x4*)(CBs + i * 68 + js0), c1v = *(const LAS f32x4*)(CBs + i * 68 + js0 + 4);
                    const f32x4 a0 = *(const LAS f32x4*)(ACUM + wid * 64 + js0), a1 = *(const LAS f32x4*)(ACUM + wid * 64 + js0 + 4);
                    const f32x4 d0 = *(const LAS f32x4*)(DTL + wid * 64 + js0), d1 = *(const LAS f32x4*)(DTL + wid * 64 + js0 + 4);
                    float l[8];
#pragma unroll
                    for (int e = 0; e < 4; ++e) { l[e] = (js0 + e <= i) ? c0v[e] * __expf(ai - a0[e]) * d0[e] : 0.f; l[4 + e] = (js0 + 4 + e <= i) ? c1v[e] * __expf(ai - a1[e]) * d1[e] : 0.f; }
                    const bf16x8 Y = __builtin_bit_cast(bf16x8, pack8(l));
#pragma unroll
                    for (int pb = 0; pb < 4; ++pb) { const bf16x8 X = *(const LAS bf16x8*)(XTh + (pb * 16 + fr) * 72 + js0); ya[pb][ib] = __builtin_amdgcn_mfma_f32_16x16x32_bf16(X, Y, ya[pb][ib], 0, 0, 0); }
                    asm volatile("" ::: "memory");
                }
#endif
            float ss[4];
#pragma unroll
            for (int ib = 0; ib < 4; ++ib) { const int i = ib * 16 + fr; ss[ib] = 0.f;
#pragma unroll
                for (int pb = 0; pb < 4; ++pb) { const int pc = pb * 16 + 4 * q; const u32x2 z2 = zz[ib][pb];
                    const float zf[4] = {bflo(z2.x), bfhi(z2.x), bflo(z2.y), bfhi(z2.y)};
#pragma unroll
                    for (int jj = 0; jj < 4; ++jj) { const float xs = bf1(XTh[(pc + jj) * 72 + i]); const float gv = (ya[pb][ib][jj] + Dh * xs) * zf[jj]; ya[pb][ib][jj] = gv; ss[ib] += gv * gv; } }
                asm volatile("" ::: "memory");
                ss[ib] += __shfl_xor(ss[ib], 16); ss[ib] += __shfl_xor(ss[ib], 32);
                if (q == 0) NP[wid * 64 + i] = ss[ib]; }
            __syncthreads();
            f32x4 wv4[4];
#pragma unroll
            for (int pb = 0; pb < 4; ++pb) wv4[pb] = *(const f32x4*)(p.in[I_SNW] + h * 64 + pb * 16 + 4 * q);
#pragma unroll
            for (int ib = 0; ib < 4; ++ib) { const int i = ib * 16 + fr; float tot = 0.f;
#pragma unroll
                for (int w8 = 0; w8 < 8; ++w8) tot += NP[w8 * 64 + i];
                const float rstd = rsqrtf(tot * (1.f / 512.f) + EPS);
#pragma unroll
                for (int pb = 0; pb < 4; ++pb) { const int pc = pb * 16 + 4 * q; const f32x4 wv = wv4[pb];
                    float ov[4] = {ya[pb][ib][0] * rstd * wv[0], ya[pb][ib][1] * rstd * wv[1], ya[pb][ib][2] * rstd * wv[2], ya[pb][ib][3] * rstd * wv[3]};
#ifdef NAN_DBG
#pragma unroll
                    for (int e = 0; e < 4; ++e) ov[e] = (fabsf(ov[e]) < 1e30f) ? ov[e] : 0.f;
#endif
                    u32x2 o; o.x = cvt_pk_bf16(ov[0], ov[1]); o.y = cvt_pk_bf16(ov[2], ov[3]);
                    if (!dry) *(u32x2*)(zrow + ib * 32768 + pb * 16) = o; } }
        }
#ifndef NO_F
        if (!WITH_Y || sample || cc + 1 < nch) {
            const float e_last = __expf(last);
            bf16x8 Ys[4][2];
#pragma unroll
            for (int ks = 0; ks < 2; ++ks) { const int js0 = ks * 32 + 8 * q;
                const f32x4 a0 = *(const LAS f32x4*)(ACUM + wid * 64 + js0), a1 = *(const LAS f32x4*)(ACUM + wid * 64 + js0 + 4);
                const f32x4 d0 = *(const LAS f32x4*)(DTL + wid * 64 + js0), d1 = *(const LAS f32x4*)(DTL + wid * 64 + js0 + 4);
                float wj[8];
#pragma unroll
                for (int e = 0; e < 4; ++e) { wj[e] = d0[e] * __expf(last - a0[e]); wj[4 + e] = d1[e] * __expf(last - a1[e]); }
#pragma unroll
                for (int pb = 0; pb < 4; ++pb) { float x[8]; unpack8(*(const LAS u32x4*)(XTh + (pb * 16 + fr) * 72 + js0), x);
#pragma unroll
                    for (int e = 0; e < 8; ++e) x[e] *= wj[e];
                    Ys[pb][ks] = __builtin_bit_cast(bf16x8, pack8(x)); } }
#pragma unroll
            for (int t = 0; t < 4; ++t) {
                u32x2 oldp[2][4]; f32x4 olds[2][4];
#pragma unroll
                for (int hf = 0; hf < 2; ++hf)
#pragma unroll
                    for (int pb = 0; pb < 4; ++pb) {
                        if (sample) olds[hf][pb] = *(const f32x4*)(Hin + pb * 2048 + (2 * t + hf) * 16);
                        else if (WITH_Y) oldp[hf][pb] = *(const u32x2*)(sentc + pb * 2048 + (2 * t + hf) * 16); }
#pragma unroll
                for (int hf = 0; hf < 2; ++hf) { const int nb = 2 * t + hf;
                    const bf16x8 X0 = *(const LAS bf16x8*)(BT + (nb * 16 + fr) * 72 + 8 * q), X1 = *(const LAS bf16x8*)(BT + (nb * 16 + fr) * 72 + 32 + 8 * q);
#pragma unroll
                    for (int pb = 0; pb < 4; ++pb) {
                        f32x4 a;
                        if (sample) { a = olds[hf][pb] * e_last; }
                        else if (WITH_Y) { const u32x2 w = oldp[hf][pb]; a = (f32x4){bflo(w.x), bfhi(w.x), bflo(w.y), bfhi(w.y)} * e_last; }
                        else { const unsigned w0 = hf ? hs[pb][t].z : hs[pb][t].x, w1 = hf ? hs[pb][t].w : hs[pb][t].y; a = (f32x4){bflo(w0), bfhi(w0), bflo(w1), bfhi(w1)} * e_last; }
                        a = __builtin_amdgcn_mfma_f32_16x16x32_bf16(X0, Ys[pb][0], a, 0, 0, 0);
                        a = __builtin_amdgcn_mfma_f32_16x16x32_bf16(X1, Ys[pb][1], a, 0, 0, 0);
                        if (sample) { if (!dry) *(f32x4*)(p.out + O_SS + (((size_t)(seq - 2) * 32 + h) * 64 + pb * 16 + fr) * 128 + nb * 16 + 4 * q) = a; }
                        else if (WITH_Y) { if (!dry) *(u32x2*)(sentc + pb * 2048 + nb * 16) = (u32x2){cvt_pk_bf16(a[0], a[1]), cvt_pk_bf16(a[2], a[3])}; }
                        else { const unsigned w0 = cvt_pk_bf16(a[0], a[1]), w1 = cvt_pk_bf16(a[2], a[3]); if (hf) { hs[pb][t].z = w0; hs[pb][t].w = w1; } else { hs[pb][t].x = w0; hs[pb][t].y = w1; } }
                    } }
                asm volatile("" ::: "memory"); }
        }
#endif
        lastsum += last;
        __syncthreads();
    }
    if (!WITH_Y) {
#pragma unroll
        for (int pb = 0; pb < 4; ++pb)
#pragma unroll
            for (int t = 0; t < 4; ++t) { bf16* s0 = Sb + (((size_t)(seq * 32 + sc) * 32 + h) * 64 + pb * 16 + fr) * 128 + 32 * t + 4 * q;
                *(u32x2*)s0 = (u32x2){hs[pb][t].x, hs[pb][t].y}; *(u32x2*)(s0 + 16) = (u32x2){hs[pb][t].z, hs[pb][t].w}; }
        if (lane == 0) CD[(seq * 32 + sc) * 32 + h] = lastsum;
    }
}

__device__ __forceinline__ void phase_scan(const KP& p, int tid, bool dry = false) {
    asm volatile("" : "+v"(tid));
    const int gid = blockIdx.x * NT + tid;
    if (gid >= 131072) return;
    const int seq = gid >> 16, rem = gid & 65535, h = rem >> 11;
    bf16* Sb = (bf16*)(p.ws + WS_S); const float* CD = (const float*)(p.ws + WS_CD);
    f32x4 hv = (f32x4){0.f, 0.f, 0.f, 0.f};
    u32x2 sv[32]; float ev[32];
#pragma unroll
    for (int sc = 0; sc < 32; ++sc) { sv[sc] = *(const u32x2*)(Sb + (size_t)(seq * 32 + sc) * 262144 + (size_t)rem * 4); ev[sc] = CD[(seq * 32 + sc) * 32 + h]; }
#pragma unroll
    for (int sc = 0; sc < 32; ++sc) {
        u32x2* sp = (u32x2*)(Sb + (size_t)(seq * 32 + sc) * 262144 + (size_t)rem * 4);
        const u32x2 s = sv[sc]; const float e = __expf(ev[sc]);
        if (!dry) *sp = (u32x2){cvt_pk_bf16(hv[0], hv[1]), cvt_pk_bf16(hv[2], hv[3])};
        hv = hv * e + (f32x4){bflo(s.x), bfhi(s.x), bflo(s.y), bfhi(s.y)};
    }
    if (!dry) *(f32x4*)(p.out + O_SP + (size_t)seq * 262144 + (size_t)rem * 4) = hv;
}

__device__ __forceinline__ float load_row_sq(f32x4 (&t)[4], const bf16* O, const float* ST, const float* SL, int ns, int m, int lane) {
    float s = 0.f;
    if (m < MP) { const u32x2* r = (const u32x2*)(O + (size_t)m * D) + lane;
#pragma unroll
        for (int j = 0; j < 4; ++j) { const u32x2 w = r[64 * j]; t[j] = (f32x4){bflo(w.x), bfhi(w.x), bflo(w.y), bfhi(w.y)}; }
        s = lane < 16 ? ST[(size_t)m * 16 + lane] : 0.f;
    } else {
#pragma unroll
        for (int j = 0; j < 4; ++j) t[j] = (f32x4){0.f, 0.f, 0.f, 0.f};
        for (int k = 0; k < ns; ++k) { const f32x4* r = (const f32x4*)(SL + ((size_t)k * MS + (m - MP)) * D) + lane;
#pragma unroll
            for (int j = 0; j < 4; ++j) t[j] = t[j] + r[64 * j]; }
#pragma unroll
        for (int j = 0; j < 4; ++j) s += (t[j][0] * t[j][0] + t[j][1] * t[j][1]) + (t[j][2] * t[j][2] + t[j][3] * t[j][3]);
    }
    return wave_sum(s);
}
__device__ __forceinline__ void phase_mgs(const KP& p, int wid, int lane) {
    asm volatile("" : "+v"(lane));
    const int gw = blockIdx.x * 8 + wid, NGW = gridDim.x * 8;
    const float* SLA = (const float*)(p.ws + WS_SLA); const float* SLB = (const float*)(p.ws + WS_SLB); const bf16* GS = (const bf16*)(p.ws + WS_GABS); bf16* MG = (bf16*)(p.ws + WS_T);
    for (int m = gw; m < MS; m += NGW) {
#pragma unroll
        for (int j = 0; j < 4; ++j) { const int col = 4 * lane + 256 * j;
            f32x4 pa = *(const f32x4*)(SLA + (size_t)m * D + col) + *(const f32x4*)(SLA + ((size_t)MS + m) * D + col);
            f32x4 pb = (*(const f32x4*)(SLB + (size_t)m * D + col) + *(const f32x4*)(SLB + ((size_t)MS + m) * D + col)) + (*(const f32x4*)(SLB + ((size_t)2 * MS + m) * D + col) + *(const f32x4*)(SLB + ((size_t)3 * MS + m) * D + col));
            const u32x2 a = *(const u32x2*)(GS + (size_t)m * 2048 + col), b = *(const u32x2*)(GS + (size_t)m * 2048 + 1024 + col);
            const f32x4 sa = (f32x4){bflo(a.x), bfhi(a.x), bflo(a.y), bfhi(a.y)}, sb = (f32x4){bflo(b.x), bfhi(b.x), bflo(b.y), bfhi(b.y)};
            const f32x4 o = sa * pa + sb * pb;
            *(u32x2*)(MG + (size_t)(MP + m) * D + col) = (u32x2){cvt_pk_bf16(o[0], o[1]), cvt_pk_bf16(o[2], o[3])}; }
    }
}
__device__ __forceinline__ void phase_x1(const KP& p, int wid, int lane) {
    asm volatile("" : "+v"(lane));
    const int gw = blockIdx.x * 8 + wid, NGW = gridDim.x * 8;
    bf16* X1N = (bf16*)(p.ws + WS_X1N);
    for (int m = gw; m < M; m += NGW) {
        f32x4 t[4]; const float rstd = rsqrtf(load_row_sq(t, (const bf16*)(p.ws + WS_T2), (const float*)(p.ws + WS_ST), (const float*)(p.ws + WS_ACO), 4, m, lane) * (1.f / D) + EPS);
        const f32x4* xr = (const f32x4*)xrow(p, m) + lane; const f32x4* wr4 = (const f32x4*)p.in[I_POSTMIX] + lane;
        f32x4 v[4]; float s2 = 0.f;
#pragma unroll
        for (int j = 0; j < 4; ++j) { v[j] = __builtin_nontemporal_load(xr + 64 * j) + t[j] * rstd * wr4[64 * j]; s2 += (v[j][0] * v[j][0] + v[j][1] * v[j][1]) + (v[j][2] * v[j][2] + v[j][3] * v[j][3]); }
        const float r2 = rsqrtf(wave_sum(s2) * (1.f / D) + EPS);
        f32x4* o = (f32x4*)(p.out + (size_t)m * D) + lane; u32x2* o2 = (u32x2*)(X1N + (size_t)m * D) + lane;
#pragma unroll
        for (int j = 0; j < 4; ++j) { __builtin_nontemporal_store(v[j], o + 64 * j); u32x2 w; w.x = cvt_pk_bf16(v[j][0] * r2, v[j][1] * r2); w.y = cvt_pk_bf16(v[j][2] * r2, v[j][3] * r2); o2[64 * j] = w; }
    }
}
__device__ __forceinline__ void phase_final(const KP& p, int wid, int lane) {
    asm volatile("" : "+v"(lane));
    const int gw = blockIdx.x * 8 + wid, NGW = gridDim.x * 8;
    for (int m = gw; m < M; m += NGW) {
        f32x4 t[4]; const float rstd = rsqrtf(load_row_sq(t, (const bf16*)(p.ws + WS_F), (const float*)(p.ws + WS_ST2), (const float*)(p.ws + WS_ACF), 8, m, lane) * (1.f / D) + EPS);
        f32x4* o = (f32x4*)(p.out + (size_t)m * D) + lane; const f32x4* wr4 = (const f32x4*)p.in[I_POSTFFN] + lane;
#pragma unroll
        for (int j = 0; j < 4; ++j) __builtin_nontemporal_store(o[64 * j] + t[j] * rstd * wr4[64 * j], o + 64 * j);
    }
}
__device__ __forceinline__ void zero_f32(float* q, int n4, int tid) {
    asm volatile("" : "+v"(tid));
    for (int i = blockIdx.x * NT + tid; i < n4; i += gridDim.x * NT) ((f32x4*)q)[i] = (f32x4){0.f, 0.f, 0.f, 0.f};
}

#define XB_TMO      128
#define XB_XCNT(j)  (256  + 64 * (j))
#define XB_XSUB(j)  (1280 + 64 * (j))
#define XB_XGEN(j)  (2304 + 64 * (j))
#define XB_TOP      3328
#define XB_TOPGEN   3392
#define XCD_BAR_WORDS 3456
#define XB_SPIN_CAP (1u << 18)

__device__ __forceinline__ unsigned xb_ld(unsigned* p)              { return __hip_atomic_load(p, __ATOMIC_RELAXED, __HIP_MEMORY_SCOPE_AGENT); }
__device__ __forceinline__ unsigned xb_add(unsigned* p, unsigned v) { return __hip_atomic_fetch_add(p, v, __ATOMIC_RELAXED, __HIP_MEMORY_SCOPE_AGENT); }
__device__ __forceinline__ unsigned xb_xcc_id() { return (unsigned)__builtin_amdgcn_s_getreg((3 << 11) | 20) & 0xFu; }
#define XB_SPIN(cond, bar) do { unsigned _sp = 0; while (cond) { __builtin_amdgcn_s_sleep(1); \
    if ((++_sp & 255u) == 0u) { if (xb_ld(&(bar)[XB_TMO])) break; if (_sp > XB_SPIN_CAP) { atomicAdd(&(bar)[XB_TMO], 1u); break; } } } } while (0)

struct XcdBarrier {
    unsigned* bar; unsigned x;
    volatile LAS unsigned* st;
};

__device__ __forceinline__ XcdBarrier xcd_barrier_post(unsigned* bar, volatile LAS unsigned* st) {
    XcdBarrier b; b.bar = bar; b.x = xb_xcc_id(); b.st = st;
    if (threadIdx.x == 0) (void)xb_add(&bar[XB_XCNT(b.x)], 1u);
    return b;
}
__device__ __forceinline__ void xcd_barrier_complete(unsigned* bar, unsigned x, unsigned& nloc, unsigned& nx) {
    const unsigned G = gridDim.x * gridDim.y * gridDim.z;
    unsigned sum, cnt, mine, sp = 0u;
    for (;;) {
        sum = 0u; cnt = 0u; mine = 0u;
#pragma unroll
        for (unsigned j = 0; j < 16; ++j) { const unsigned c = xb_ld(&bar[XB_XCNT(j)]); sum += c; cnt += (c > 0u) ? 1u : 0u; mine = (j == x) ? c : mine; }
        if (sum == G) break;
        __builtin_amdgcn_s_sleep(1);
        if ((++sp & 255u) == 0u) { if (xb_ld(&bar[XB_TMO])) break; if (sp > XB_SPIN_CAP) { atomicAdd(&bar[XB_TMO], 1u); break; } }
    }
    nloc = mine > 0u ? mine : 1u; nx = cnt > 0u ? cnt : 1u;
}

__device__ __forceinline__ void xcd_barrier(const XcdBarrier& b) {
    asm volatile("s_waitcnt vmcnt(0)" ::: "memory");
    __syncthreads();
    if (threadIdx.x == 0) {
        unsigned* bar = b.bar;
        __builtin_amdgcn_s_waitcnt(0);
        unsigned nloc = b.st[0], nx = b.st[1];
        if (nloc == 0u) { xcd_barrier_complete(bar, b.x, nloc, nx); b.st[0] = nloc; b.st[1] = nx; }
        const unsigned old = xb_add(&bar[XB_XSUB(b.x)], 1u);
        const unsigned gen = old / nloc;
        if (old + 1u == (gen + 1u) * nloc) {
            __builtin_amdgcn_fence(__ATOMIC_RELEASE, "agent");
            asm volatile("s_waitcnt vmcnt(0)" ::: "memory");
            const unsigned og = xb_add(&bar[XB_TOP], 1u);
            const unsigned tg = og / nx;
            if (og + 1u == (tg + 1u) * nx) xb_add(&bar[XB_TOPGEN], 1u);
            else XB_SPIN(xb_ld(&bar[XB_TOPGEN]) == tg, bar);
            __builtin_amdgcn_fence(__ATOMIC_ACQUIRE, "agent");
            xb_add(&bar[XB_XGEN(b.x)], 1u);
            asm volatile("s_waitcnt vmcnt(0)" ::: "memory");
        } else {
            XB_SPIN(xb_ld(&bar[XB_XGEN(b.x)]) == gen, bar);
            __builtin_amdgcn_fence(__ATOMIC_ACQUIRE, "agent");
            asm volatile("s_waitcnt vmcnt(0)" ::: "memory");
        }
    }
    __syncthreads();
}

constexpr int NPHASE = 14;
__global__ void __launch_bounds__(NT, 2) hybrid_fwd(KP p) {
#define RELOAD_P() do { } while (0)
    extern __shared__ __attribute__((aligned(16))) unsigned char lds_raw[];
    LAS unsigned char* lds = (LAS unsigned char*)lds_raw;
    const int tid = threadIdx.x, lane = tid & 63, wid = __builtin_amdgcn_readfirstlane(tid >> 6);
    const int G = gridDim.x, c = blockIdx.x;
    unsigned char* ws = p.ws;
    const int lo = p.ph_lo, hi = p.ph_hi;
#ifndef PHMASK
#define PHMASK 0x7fff
#endif
#if MK_LAUNCHES == 1
#define IN(k) (((PHMASK >> (k)) & 1) != 0)
#else
#define IN(k) (((PHMASK >> (k)) & 1) && lo <= (k) && (k) < hi)
#endif
#ifndef DUPMASK
#define DUPMASK 0
#endif
#define REP(k) for (int rep_ = 0; rep_ < (((DUPMASK >> (k)) & 1) ? 2 : 1); ++rep_)
#if MK_LAUNCHES == 1
#define SEAM(k) do { if (IN(k) && IN((k) + 1)) xcd_barrier(xbar); } while (0)
#else
#define SEAM(k) do { } while (0)
#endif
    volatile LAS unsigned* xst = (volatile LAS unsigned*)(lds + LDS_BYTES - 64);
    if (tid < 2) xst[tid] = 0u;
    __syncthreads();
    XcdBarrier xbar; xbar.bar = (unsigned*)ws; xbar.x = 0; xbar.st = xst;
#if MK_LAUNCHES == 1
    xbar = xcd_barrier_post((unsigned*)ws, xst);
#endif
    if (hi < 0) cg::this_grid().sync();
    bf16* Win = (bf16*)(ws + WS_WIN);
    RELOAD_P();
    if (IN(0)) phase_prologue(p, lds, wid, lane, 0);
    SEAM(0);
    RELOAD_P();
    if (IN(1)) {
        pg8::Gemm g{(const bf16*)(ws + WS_XN), Win, M, 7424, D}; pg8::InOrder S; S.init(M, 7424, G, c);
        EpiIn E{EpiUV{(bf16*)(ws + WS_U), (bf16*)(ws + WS_G), (f32x2v*)(ws + WS_VST)}, EpiZXD{(bf16*)p.out, (bf16*)(ws + WS_XBC), (float*)(ws + WS_DT), p.in[I_DTB], p.out}, EpiG{(bf16*)(ws + WS_GABS), MP}};
        pg8::gemm_phase<EpiIn, pg8::InOrder, true, true>(lds, g, S, E);
    }
    SEAM(1);
    RELOAD_P();
    if (IN(2)) {
        if (c < 64) { ssd_unit<true, true>(p, lds, 2 + (c >> 2), 0, c & 3, tid, wid, lane);
            for (int u = c; u < 128; u += 64) gmlp_unit(p, lds, u >> 3, u & 7, tid, wid, lane); }
        else { for (int u = 128 + (c - 64); u < 144 * 8; u += G - 64) gmlp_unit(p, lds, u >> 3, u & 7, tid, wid, lane);
            phase_prologue(p, lds, wid, lane, 1, (c - 64) * 8 + wid, (G - 64) * 8); }
    }
    SEAM(2);
    RELOAD_P();
    if (IN(3)) { for (int u = c; u < 256; u += G) ssd_unit<false, false>(p, lds, u >> 7, (u >> 2) & 31, u & 3, tid, wid, lane); }
    SEAM(3);
    RELOAD_P();
    if (IN(4)) phase_scan(p, tid);
    SEAM(4);
    RELOAD_P();
    if (IN(5)) { for (int u = c; u < 256; u += G) ssd_unit<true, false>(p, lds, u >> 7, (u >> 2) & 31, u & 3, tid, wid, lane); }
    SEAM(5);
#pragma clang loop unroll(disable)
    for (int ph = 6; ph <= 13; ++ph) {
        RELOAD_P();
        if (IN(ph)) {
            if (ph == 9) phase_mgs(p, wid, lane);
            else if (ph == 11) phase_x1(p, wid, lane);
            else if (ph == 12) {
                pg8::Gemm g{(const bf16*)(ws + WS_X1N), (const bf16*)(ws + WS_WUP), M, FF, D}; pg8::StaticOrder S; S.init(M, FF, G, c);
                EpiUp E{(bf16*)(ws + WS_H)};
                pg8::gemm_phase<EpiUp, pg8::StaticOrder, true, true>(lds, g, S, E);
            } else {
                const bf16* A; const bf16* B; int K, log_ns, nk, gate = 0; EpiGen E; E.GAB = (const bf16*)(ws + WS_GAB); E.T = (const bf16*)(ws + WS_T); E.ST = (float*)(ws + WS_ST);
                if (ph == 6)       { A = (const bf16*)(ws + WS_XN); B = Win + (size_t)7424 * D;     K = D;    log_ns = 0; nk = 0; E.mode = 3; E.O = (bf16*)(ws + WS_GAB); E.SL = nullptr; E.kb_shift = 0; gate = 1; }
                else if (ph == 7)  { A = (const bf16*)(ws + WS_U);  B = (const bf16*)(ws + WS_WA);  K = D;    log_ns = 1; nk = 8; E.mode = 0; E.O = (bf16*)(ws + WS_T);  E.SL = (float*)(ws + WS_SLA); E.kb_shift = 10; }
                else if (ph == 8)  { A = (const bf16*)p.out;        B = (const bf16*)(ws + WS_WB);  K = 2048; log_ns = 2; nk = 8; E.mode = 1; E.O = (bf16*)(ws + WS_T);  E.SL = (float*)(ws + WS_SLB); E.kb_shift = 10; }
                else if (ph == 10) { A = (const bf16*)(ws + WS_T);  B = (const bf16*)(ws + WS_WO);  K = D;    log_ns = 2; nk = 4; E.mode = 2; E.O = (bf16*)(ws + WS_T2); E.SL = (float*)(ws + WS_ACO); E.kb_shift = 9; }
                else               { A = (const bf16*)(ws + WS_H);  B = (const bf16*)(ws + WS_WDN); K = FF;   log_ns = 3; nk = 8; E.mode = 2; E.O = (bf16*)(ws + WS_F);  E.SL = (float*)(ws + WS_ACF); E.kb_shift = 10; }
                pg8::Gemm g{A, B, M, D, K}; pg8::TailOrder S; S.init(log_ns, nk, G, c, gate, ph == 8 ? 32 : 0);
                pg8::gemm_phase<EpiGen, pg8::TailOrder, true, true>(lds, g, S, E);
            }
        }
        if (ph == 6 || ph == 7) __syncthreads();
        else if (IN(ph) && IN(ph + 1)) xcd_barrier(xbar);
    }
    RELOAD_P();
    if (IN(14)) phase_final(p, wid, lane);
#undef IN
#undef SEAM
#undef RELOAD_P
}

extern "C" void kernel_launch(void* const* d_in, const int* in_sizes, int n_in, void* d_out, int out_size, void* d_ws, size_t ws_size, hipStream_t stream) {
    static int grid = 0;
    if (grid == 0) {
        if (n_in != 24 || ws_size < WS_END) { fprintf(stderr, "kernel_launch: unexpected n_in %d / ws_size %zu\n", n_in, ws_size); grid = -1; return; }
        int dev = 0, cus = 0, per_cu = 0;
        hipGetDevice(&dev); hipDeviceGetAttribute(&cus, hipDeviceAttributeMultiprocessorCount, dev);
        hipFuncSetAttribute((const void*)hybrid_fwd, hipFuncAttributeMaxDynamicSharedMemorySize, LDS_BYTES);
        hipOccupancyMaxActiveBlocksPerMultiprocessor(&per_cu, (const void*)hybrid_fwd, NT, LDS_BYTES);
        (void)hipGetLastError();
        if (per_cu < 1) fprintf(stderr, "kernel_launch: occupancy query says %d blocks/CU\n", per_cu);
        grid = cus;
    }
    if (grid < 0) return;
    KP a{};
    for (int i = 0; i < 24; ++i) a.in[i] = (const float*)d_in[i];
    a.out = (float*)d_out; a.ws = (unsigned char*)d_ws;
#if MK_LAUNCHES == 1
    (void)hipMemsetAsync(d_ws, 0, 16384, stream);
    a.ph_lo = 0; a.ph_hi = NPHASE + 1;
    void* args[] = {&a};
    hipError_t e = hipLaunchCooperativeKernel((const void*)hybrid_fwd, dim3(grid), dim3(NT), args, LDS_BYTES, stream);
    if (e != hipSuccess) fprintf(stderr, "cooperative launch failed: %s (grid %d)\n", hipGetErrorString(e), grid);
#else
#ifndef LASTPH
#define LASTPH NPHASE
#endif
    for (int k = 0; k <= LASTPH; ++k) { a.ph_lo = k; a.ph_hi = k + 1; hipLaunchKernelGGL(hybrid_fwd, dim3(grid), dim3(NT), LDS_BYTES, stream, a); }
#endif
}
```

```cpp
#include <hip/hip_runtime.h>
#include <hip/hip_cooperative_groups.h>
#include <cstdio>
#include <cstdint>
namespace cg = cooperative_groups;
namespace pg8 {
#define PG8_LAS __attribute__((address_space(3)))
typedef unsigned short bf16_t;
typedef short bf16x8 __attribute__((ext_vector_type(8)));
typedef float f32x4 __attribute__((ext_vector_type(4)));
typedef unsigned u32x4 __attribute__((ext_vector_type(4)));
constexpr int BM = 256, BK = 64, HALF = 128, HTB = HALF * BK * 2  , STAGE_BYTES = 8 * HTB, NXCD = 8, WGM = 8;

__host__ __device__ __forceinline__ int lds_byte(int r, int c) { const int st = (r >> 4) * 2 + (c >> 5), rr = r & 15, cc = c & 31, ob = rr * 64 + cc * 2; return st * 1024 + (ob ^ (((ob >> 9) & 1) << 5)); }
__host__ __device__ __forceinline__ void stage_rc(int b, int& R, int& C) { const int st = b / 1024, sb = b % 1024, swz = sb ^ (((sb >> 9) & 1) << 5); R = (st >> 1) * 16 + swz / 64; C = (st & 1) * 32 + (swz % 64) / 2; }
__host__ __device__ __forceinline__ int perm32(int rho) { const int n = rho >> 4, i = rho & 15; return 8 * (i >> 2) + 4 * n + (i & 3); }

struct Unit { int pm, pn, kb, nk; };
struct Gemm { const bf16_t* A; const bf16_t* Bt; int M, N, K; };

struct StaticOrder {
    int nM, nN, nwg, G, c;
    __host__ __device__ void init(int M, int N, int G_, int c_) { nM = M / BM; nN = N / BM; nwg = nM * nN; G = G_; c = c_; }
    __host__ __device__ bool next(int i, Unit& u) const {
        const long L = (long)i * G + c; if (L >= nwg) return false;
        int wgid = (int)L; { const int q = nwg / NXCD, r = nwg % NXCD, xcd = wgid % NXCD, off = wgid / NXCD; wgid = (xcd < r ? xcd * (q + 1) : r * (q + 1) + (xcd - r) * q) + off; }
        const int nig = WGM * nN, gid = wgid / nig, fm = gid * WGM, gsz = (nM - fm) < WGM ? (nM - fm) : WGM;
        u.pm = fm + ((wgid % nig) % gsz); u.pn = (wgid % nig) / gsz; u.kb = 0; u.nk = 0; return true;
    }
    __device__ __forceinline__ void a_ready(const Unit&) const {}
    __device__ __forceinline__ void done(const Unit&) const {}
};
struct InOrder {
    StaticOrder so; int np, G, cx;
    __host__ __device__ void init(int M, int N, int G_, int c_) { so.init(M, N, G_, c_); np = c_ < so.nwg ? (so.nwg - c_ + G_ - 1) / G_ : 0; G = G_; cx = (c_ - (so.nwg % G_) + G_) % G_; }
    __host__ __device__ bool next(int i, Unit& u) const {
        if (i < np) return so.next(i, u);
        const int l = (i - np) * G + cx; if (l >= 32) return false;
        u.pm = 64 + (l >> 3); u.pn = 29 + (l & 7); u.kb = 0; u.nk = 0; return true;
    }
    __device__ __forceinline__ void a_ready(const Unit&) const {}
    __device__ __forceinline__ void done(const Unit&) const {}
};
struct TailOrder {
    StaticOrder so; int np, n, G, c, log_ns, nk, gate, cx;
    __host__ __device__ void init(int log_ns_, int nk_, int G_, int c_, int gate_ = 0, int coff = 0) { cx = (c_ - coff % G_ + G_) % G_; so.init(64 * BM, 4 * BM, G_, c_); np = c_ < so.nwg ? (so.nwg - c_ + G_ - 1) / G_ : 0; log_ns = log_ns_; nk = nk_; n = gate_ ? 0 : (16 << log_ns_); G = G_; c = c_; gate = gate_; if (gate_) np *= 2; }
    __host__ __device__ bool next(int i, Unit& u) const {
        if (i < np) { if (!gate) return so.next(i, u); const bool ok = so.next(i >> 1, u); u.pn += 4 * (i & 1); return ok; }
        const int l = (i - np) * G + cx; if (l >= n) return false;
        u.kb = (l & ((1 << log_ns) - 1)) * (nk * BK * 2); u.nk = nk; const int t = l >> log_ns; u.pn = t & 3; u.pm = 64 + (t >> 2); return true;
    }
    __device__ __forceinline__ void a_ready(const Unit&) const {}
    __device__ __forceinline__ void done(const Unit&) const {}
};

__device__ __forceinline__ unsigned cvt_pk_bf16(float lo, float hi) { unsigned r; asm volatile("v_cvt_pk_bf16_f32 %0, %1, %2" : "=v"(r) : "v"(lo), "v"(hi)); return r; }
typedef float f32x2 __attribute__((ext_vector_type(2)));
template <class Epi, class Sched, bool ALIGN_EPI = false, bool SP2 = false>
__device__ __forceinline__ void gemm_phase(PG8_LAS unsigned char* lds, const Gemm g, const Sched& S, const Epi& E) {
    int tid_ = threadIdx.x; asm volatile("" : "+v"(tid_));
    const int tid = tid_, wid = __builtin_amdgcn_readfirstlane(tid >> 6), lane = tid & 63, wr = wid >> 2, wc = wid & 3, fr = lane & 15, fq = lane >> 4;
    const int K = g.K, ntfull = K / BK;
    unsigned voffA[2], voffB[2];
#pragma unroll
    for (int i = 0; i < 2; ++i) { int R, C; stage_rc(tid * 16 + i * 8192, R, C); const int Rb = Epi::PERM ? ((R & ~31) + perm32(R & 31)) : R;
        voffA[i] = (unsigned)(R * K + C) * 2u; voffB[i] = (unsigned)(Rb * K + C) * 2u; }
    const size_t kstep = (size_t)(BK * 2);
    const size_t hstep = (size_t)HALF * K * 2;
    const size_t tstep = 2 * hstep;
    const unsigned ldsw = (unsigned)wid * 1024u;
    const int aoff = lds_byte(wr * 64 + fr, fq * 8), boff = lds_byte(wc * 32 + fr, fq * 8);
#define PG8_SA(b, h) (((b) * 2 + (h)) * HTB)
#define PG8_SB(b, h) ((4 + (b) * 2 + (h)) * HTB)
#define PG8_STAGE(bufoff, gbase, voff) do { _Pragma("unroll") for (int _i = 0; _i < 2; ++_i) \
        __builtin_amdgcn_global_load_lds((const unsigned*)((const char*)(gbase) + (voff)[_i]), (PG8_LAS unsigned*)(lds + (bufoff) + ldsw + _i * 8192), 16, 0, 0); } while (0)
#define PG8_LDA(dst, b, h) do { _Pragma("unroll") for (int m = 0; m < 4; ++m) _Pragma("unroll") for (int k = 0; k < 2; ++k) dst[m][k] = *(const PG8_LAS bf16x8*)(lds + PG8_SA(b, h) + aoff + m * 2048 + k * 1024); } while (0)
#define PG8_LDB(dst, b, h) do { _Pragma("unroll") for (int n = 0; n < 2; ++n) _Pragma("unroll") for (int k = 0; k < 2; ++k) dst[n][k] = *(const PG8_LAS bf16x8*)(lds + PG8_SB(b, h) + boff + n * 2048 + k * 1024); } while (0)
#define PG8_MMA(ai, bj, At, Bt) do { __builtin_amdgcn_s_setprio(1); _Pragma("unroll") for (int m = 0; m < 4; ++m) _Pragma("unroll") for (int n = 0; n < 2; ++n) _Pragma("unroll") for (int k = 0; k < 2; ++k) \
        acc[ai][bj][m][n] = __builtin_amdgcn_mfma_f32_16x16x32_bf16(Bt[n][k], At[m][k], acc[ai][bj][m][n], 0, 0, 0); __builtin_amdgcn_s_setprio(0); } while (0)
#define PG8_WAIT_V(n) asm volatile("s_waitcnt vmcnt(" #n ")" ::: "memory")
#define PG8_WAIT_L(n) asm volatile("s_waitcnt lgkmcnt(" #n ")" ::: "memory")
#define PG8_BAR __builtin_amdgcn_s_barrier()
#define PG8_SCHED __builtin_amdgcn_sched_barrier(0)
    Unit cur, nxt; int ui = 0;
    if (!S.next(0, cur)) return;
    f32x4 acc[2][2][4][2];
#pragma unroll
    for (int a = 0; a < 2; ++a)
#pragma unroll
        for (int b = 0; b < 2; ++b)
#pragma unroll
            for (int m = 0; m < 4; ++m)
#pragma unroll
                for (int n = 0; n < 2; ++n) acc[a][b][m][n] = (f32x4){0.f, 0.f, 0.f, 0.f};
    bf16x8 At[4][2], B0[2][2], B1[2][2];
    const char* cA = (const char*)g.A + (size_t)cur.pm * tstep + cur.kb; const char* cB = (const char*)g.Bt + (size_t)cur.pn * tstep + cur.kb;
    S.a_ready(cur);
    if constexpr (SP2) {
        PG8_STAGE(PG8_SB(0, 0), cB, voffB); PG8_STAGE(PG8_SB(0, 1), cB + hstep, voffB); PG8_STAGE(PG8_SA(0, 0), cA, voffA); PG8_STAGE(PG8_SA(0, 1), cA + hstep, voffA);
        if (wr == 1) PG8_BAR;
        PG8_WAIT_V(2); PG8_BAR;
        PG8_STAGE(PG8_SB(1, 0), cB + kstep, voffB); PG8_STAGE(PG8_SA(1, 0), cA + kstep, voffA); PG8_STAGE(PG8_SB(1, 1), cB + hstep + kstep, voffB);
        PG8_WAIT_V(6); PG8_BAR;
    } else {
        PG8_STAGE(PG8_SB(0, 0), cB, voffB); PG8_STAGE(PG8_SA(0, 0), cA, voffA); PG8_STAGE(PG8_SB(0, 1), cB + hstep, voffB); PG8_STAGE(PG8_SA(0, 1), cA + hstep, voffA);
        if (wr == 1) PG8_BAR;
        PG8_WAIT_V(4); PG8_BAR;
        PG8_STAGE(PG8_SB(1, 0), cB + kstep, voffB); PG8_STAGE(PG8_SA(1, 0), cA + kstep, voffA); PG8_STAGE(PG8_SB(1, 1), cB + hstep + kstep, voffB);
        PG8_WAIT_V(6); PG8_BAR;
    }
    for (;;) {
        const bool has_next = S.next(ui + 1, nxt);
        const char* nA = has_next ? (const char*)g.A + (size_t)nxt.pm * tstep + nxt.kb : cA; const char* nB = has_next ? (const char*)g.Bt + (size_t)nxt.pn * tstep + nxt.kb : cB;
        const int nt = cur.nk ? cur.nk : ntfull;
        for (int t = 0; t < nt; t += 2) {
            const bool last = (t == nt - 2);
            const char* a1 = cA + (size_t)(t + 1) * kstep;
            const char* a2 = last ? nA : cA + (size_t)(t + 2) * kstep; const char* b2 = last ? nB : cB + (size_t)(t + 2) * kstep;
            const char* a3 = a2 + kstep; const char* b3 = b2 + kstep;
            if (last && has_next) S.a_ready(nxt);
            if constexpr (SP2) {
            PG8_LDB(B0, 0, 0); PG8_LDB(B1, 0, 1); PG8_SCHED; PG8_LDA(At, 0, 0); PG8_STAGE(PG8_SA(1, 1), a1 + hstep, voffA);
            PG8_WAIT_V(8); PG8_WAIT_L(0); PG8_BAR; PG8_MMA(0, 0, At, B0); PG8_MMA(0, 1, At, B1); PG8_BAR; PG8_SCHED;
            PG8_LDA(At, 0, 1); PG8_STAGE(PG8_SB(0, 0), b2, voffB); PG8_STAGE(PG8_SB(0, 1), b2 + hstep, voffB); PG8_STAGE(PG8_SA(0, 0), a2, voffA);
            PG8_WAIT_V(8); PG8_WAIT_L(0); PG8_BAR; PG8_MMA(1, 0, At, B0); PG8_MMA(1, 1, At, B1); PG8_BAR; PG8_SCHED;
            PG8_LDB(B0, 1, 0); PG8_LDB(B1, 1, 1); PG8_SCHED; PG8_LDA(At, 1, 0); PG8_STAGE(PG8_SA(0, 1), a2 + hstep, voffA);
            PG8_WAIT_V(8); PG8_WAIT_L(0); PG8_BAR; PG8_MMA(0, 0, At, B0); PG8_MMA(0, 1, At, B1); PG8_BAR; PG8_SCHED;
            PG8_LDA(At, 1, 1); PG8_STAGE(PG8_SB(1, 0), b3, voffB); PG8_STAGE(PG8_SB(1, 1), b3 + hstep, voffB); PG8_STAGE(PG8_SA(1, 0), a3, voffA);
            PG8_WAIT_V(8); PG8_WAIT_L(0); PG8_BAR; PG8_MMA(1, 0, At, B0); PG8_MMA(1, 1, At, B1); PG8_BAR; PG8_SCHED;
            } else {
            PG8_LDB(B0, 0, 0); PG8_SCHED; PG8_LDA(At, 0, 0); PG8_STAGE(PG8_SA(1, 1), a1 + hstep, voffA);
            PG8_WAIT_L(8); PG8_BAR; PG8_WAIT_L(0); PG8_MMA(0, 0, At, B0); PG8_BAR; PG8_SCHED;
            PG8_LDB(B1, 0, 1); PG8_STAGE(PG8_SB(0, 0), b2, voffB);
            PG8_BAR; PG8_WAIT_L(0); PG8_MMA(0, 1, At, B1); PG8_BAR;
            PG8_LDA(At, 0, 1); PG8_STAGE(PG8_SA(0, 0), a2, voffA);
            PG8_BAR; PG8_WAIT_L(0); PG8_MMA(1, 0, At, B0); PG8_BAR; PG8_SCHED;
            PG8_STAGE(PG8_SB(0, 1), b2 + hstep, voffB);
            PG8_WAIT_V(6); PG8_BAR; PG8_MMA(1, 1, At, B1); PG8_BAR;
            PG8_LDB(B0, 1, 0); PG8_SCHED; PG8_LDA(At, 1, 0); PG8_STAGE(PG8_SA(0, 1), a2 + hstep, voffA);
            PG8_WAIT_L(8); PG8_BAR; PG8_WAIT_L(0); PG8_MMA(0, 0, At, B0); PG8_BAR; PG8_SCHED;
            PG8_LDB(B1, 1, 1); PG8_STAGE(PG8_SB(1, 0), b3, voffB);
            PG8_BAR; PG8_WAIT_L(0); PG8_MMA(0, 1, At, B1); PG8_BAR;
            PG8_LDA(At, 1, 1); PG8_STAGE(PG8_SA(1, 0), a3, voffA);
            PG8_BAR; PG8_WAIT_L(0); PG8_MMA(1, 0, At, B0); PG8_BAR; PG8_SCHED;
            PG8_STAGE(PG8_SB(1, 1), b3 + hstep, voffB);
            PG8_WAIT_V(6); PG8_BAR; PG8_MMA(1, 1, At, B1); PG8_BAR;
            }
        }
        if constexpr (ALIGN_EPI) { if (wr == 0) PG8_BAR; }
        if constexpr (!Epi::AFTER_DRAIN) { E(acc, cur, wr, wc, fr, fq); S.done(cur); }
        if (!has_next) break;
#pragma unroll
        for (int a = 0; a < 2; ++a)
#pragma unroll
            for (int b = 0; b < 2; ++b)
#pragma unroll
                for (int m = 0; m < 4; ++m)
#pragma unroll
                    for (int n = 0; n < 2; ++n) acc[a][b][m][n] = (f32x4){0.f, 0.f, 0.f, 0.f};
        cur = nxt; cA = nA; cB = nB; ++ui;
        if constexpr (ALIGN_EPI) { if (wr == 1) PG8_BAR; }
    }
    PG8_WAIT_V(0);
    if constexpr (!ALIGN_EPI) { if (wr == 0) PG8_BAR; }
    PG8_BAR;
    if constexpr (Epi::AFTER_DRAIN) { E.fused(acc, cur, wr, wc, fr, fq, lds, wid, lane); S.done(cur); }
#undef PG8_SA
#undef PG8_SB
#undef PG8_STAGE
#undef PG8_LDA
#undef PG8_LDB
#undef PG8_MMA
#undef PG8_WAIT_V
#undef PG8_WAIT_L
#undef PG8_BAR
#undef PG8_SCHED
}
}

#ifndef MK_LAUNCHES
#define MK_LAUNCHES 1
#endif
#define LAS __attribute__((address_space(3)))
typedef unsigned short bf16;
using pg8::bf16x8; using pg8::f32x4; using pg8::u32x4; using pg8::Unit;
typedef __bf16 bf16x2_t __attribute__((ext_vector_type(2)));
typedef float f32x2_t __attribute__((ext_vector_type(2)));
__device__ __forceinline__ unsigned cvt_pk_bf16(float lo, float hi) { const f32x2_t f = {lo, hi}; const bf16x2_t b = __builtin_convertvector(f, bf16x2_t); return __builtin_bit_cast(unsigned, b); }
typedef unsigned u32x2 __attribute__((ext_vector_type(2)));
typedef float f32x2v __attribute__((ext_vector_type(2)));

constexpr int NT = 512;
constexpr int D = 1024, MP = 16384, MS = 1024, M = MP + MS, FF = 4096;
constexpr int NIN = 9248;
constexpr float EPS = 1e-6f;
constexpr int LDS_BYTES = 147456;
constexpr size_t O_CP = 17825792, O_SP = 17844224, O_CS = 18368512, O_SS = 18515968, O_VS = 22710272;
constexpr size_t HM = 512 * 1024;
constexpr size_t SH = 1032192;
constexpr size_t WS_WIN = 2 * HM - SH, WS_WA = 39 * HM - SH, WS_WB = 43 * HM - SH, WS_WO = 51 * HM - SH, WS_WUP = 55 * HM - SH, WS_WDN = 71 * HM - SH;
constexpr size_t WS_XN = 87 * HM - SH, WS_U = 155 * HM - SH, WS_G = 223 * HM - SH, WS_XBC = 291 * HM - SH;
constexpr size_t WS_VST = 495 * HM - SH, WS_DT = WS_VST + 2228224, WS_CD = WS_DT + 2228224, WS_ST = WS_CD + 8192, WS_ST2 = WS_ST  , WS_END = 512 * HM;
constexpr size_t WS_GABS = 504 * HM;
static_assert(WS_ST + 1114112 <= WS_GABS && WS_WIN == 16384, "tail of the d_ws map");
constexpr size_t WS_S = WS_G, WS_GAB = 223 * HM - SH, WS_T = 359 * HM - SH, WS_MG = WS_XN, WS_T2 = 223 * HM - SH, WS_X1N = 359 * HM - SH, WS_H = 87 * HM - SH, WS_F = 359 * HM - SH;
constexpr size_t WS_SLA = 427 * HM - SH, WS_SLB = 443 * HM - SH;
constexpr size_t WS_ACO = 427 * HM - SH, WS_ACF = 423 * HM - SH;

struct KP { const float* in[24]; float* out; unsigned char* ws; int ph_lo, ph_hi; };
enum { I_XP = 0, I_XS, I_CACHE, I_STATE, I_PREMIX, I_WIN, I_LNW, I_LNB, I_GWS, I_GBS, I_CONVW, I_CONVB, I_DTB, I_ALOG, I_DSKIP, I_SNW, I_WA, I_WB, I_WO, I_POSTMIX, I_PREFFN, I_WUP, I_WDN, I_POSTFFN };

__device__ __forceinline__ float bflo(unsigned w) { return __uint_as_float(w << 16); }
__device__ __forceinline__ float bfhi(unsigned w) { return __uint_as_float(w & 0xffff0000u); }
__device__ __forceinline__ float bf1(unsigned short b) { return __uint_as_float((unsigned)b << 16); }
__device__ __forceinline__ float fsigmoid(float x) { return __builtin_amdgcn_rcpf(1.f + __expf(-x)); }
__device__ __forceinline__ float fsilu(float x) { return x * fsigmoid(x); }
__device__ __forceinline__ float fgelu(float x) { const float t = x * (1.5957691216f + 0.0713548163f * x * x); return x * __builtin_amdgcn_rcpf(1.f + __expf(-t)); }
__device__ __forceinline__ float wave_sum(float v) {
#pragma unroll
    for (int o = 1; o < 64; o <<= 1) v += __shfl_xor(v, o);
    return v;
}
__device__ __forceinline__ u32x4 pack8(const float (&a)[8]) { u32x4 w; w.x = cvt_pk_bf16(a[0], a[1]); w.y = cvt_pk_bf16(a[2], a[3]); w.z = cvt_pk_bf16(a[4], a[5]); w.w = cvt_pk_bf16(a[6], a[7]); return w; }
__device__ __forceinline__ void unpack8(const u32x4 w, float (&a)[8]) { a[0] = bflo(w.x); a[1] = bfhi(w.x); a[2] = bflo(w.y); a[3] = bfhi(w.y); a[4] = bflo(w.z); a[5] = bfhi(w.z); a[6] = bflo(w.w); a[7] = bfhi(w.w); }
__device__ __forceinline__ const float* xrow(const KP& p, int m) { return m < MP ? p.in[I_XP] + (size_t)m * D : p.in[I_XS] + (size_t)(m - MP) * D; }

#define EPI_ROWS_BEGIN _Pragma("unroll") for (int ai = 0; ai < 2; ++ai) _Pragma("unroll") for (int m = 0; m < 4; ++m) { const int row = u.pm * 256 + ai * 128 + wr * 64 + m * 16 + fr;
#define EPI_COLS_BEGIN _Pragma("unroll") for (int bj = 0; bj < 2; ++bj) { const int col = u.pn * 256 + bj * 128 + wc * 32 + 8 * fq; \
        float v[8]; { const f32x4 v0 = acc[ai][bj][m][0], v1 = acc[ai][bj][m][1]; v[0] = v0[0]; v[1] = v0[1]; v[2] = v0[2]; v[3] = v0[3]; v[4] = v1[0]; v[5] = v1[1]; v[6] = v1[2]; v[7] = v1[3]; }
#define EPI_END }
typedef const f32x4 (&AccRef)[2][2][4][2];

struct EpiUV {
    static constexpr bool PERM = true, AFTER_DRAIN = false; bf16* U; bf16* G; f32x2v* VST;
    __device__ __forceinline__ void operator()(AccRef acc, const Unit& u, int wr, int wc, int fr, int fq) const {
        const bool isv = u.pn >= 4; bf16* base = isv ? G : U;
        EPI_ROWS_BEGIN float s = 0.f, s2 = 0.f;
            EPI_COLS_BEGIN
#pragma unroll
                for (int e = 0; e < 8; ++e) { v[e] = fgelu(v[e]); s += v[e]; s2 += v[e] * v[e]; }
                *(u32x4*)(base + (size_t)row * 1024 + (col & 1023)) = pack8(v);
            EPI_END
            if (isv) { s += __shfl_xor(s, 16); s += __shfl_xor(s, 32); s2 += __shfl_xor(s2, 16); s2 += __shfl_xor(s2, 32);
                if (fq == 0) VST[(size_t)row * 16 + (u.pn - 4) * 4 + wc] = (f32x2v){s, s2}; }
        EPI_END
    }
};
struct EpiZXD {
    static constexpr bool PERM = true, AFTER_DRAIN = false; bf16* Z; bf16* XBC; float* DT; const float* dtb; float* out;
    __device__ __forceinline__ void operator()(AccRef acc, const Unit& u, int wr, int wc, int fr, int fq) const {
        EPI_ROWS_BEGIN
            EPI_COLS_BEGIN
                if (u.pn < 8) {
#pragma unroll
                    for (int e = 0; e < 8; ++e) v[e] = fsilu(v[e]);
                    __builtin_nontemporal_store(pack8(v), (u32x4*)(Z + (size_t)row * 2048 + col));
                } else if (u.pn < 20) {
                    const int c = col - 2048;
                    *(u32x4*)(XBC + (size_t)row * 3072 + c) = pack8(v);
                    int k; size_t o;
                    if (row < MP) { k = (row & 8191) - 8189; o = O_CP + ((size_t)(row >> 13) * 3 + k) * 3072 + c; }
                    else { k = ((row - MP) & 63) - 61; o = O_CS + ((size_t)((row - MP) >> 6) * 3 + k) * 3072 + c; }
                    if (k >= 0) { *(f32x4*)(out + o) = (f32x4){v[0], v[1], v[2], v[3]}; *(f32x4*)(out + o + 4) = (f32x4){v[4], v[5], v[6], v[7]}; }
                } else if (bj == 0 && wc == 0) {
                    int c = 8 * fq; asm volatile("" : "+v"(c));
#pragma unroll
                    for (int e = 0; e < 8; ++e) { const float x = v[e] + dtb[c + e]; v[e] = x > 15.f ? x : log1pf(__expf(x)); }
                    *(f32x4*)(DT + (size_t)row * 32 + c) = (f32x4){v[0], v[1], v[2], v[3]}; *(f32x4*)(DT + (size_t)row * 32 + c + 4) = (f32x4){v[4], v[5], v[6], v[7]};
                }
            EPI_END
        EPI_END
    }
};
struct EpiG {
    static constexpr bool PERM = true, AFTER_DRAIN = false; bf16* GAB; int roff;
    __device__ __forceinline__ void operator()(AccRef acc, const Unit& u, int wr, int wc, int fr, int fq) const {
        EPI_ROWS_BEGIN EPI_COLS_BEGIN
#pragma unroll
            for (int e = 0; e < 8; ++e) v[e] = fsigmoid(v[e]);
            *(u32x4*)(GAB + (size_t)(row - roff) * 2048 + col) = pack8(v);
        EPI_END EPI_END
    }
};
struct EpiIn {
    static constexpr bool PERM = true, AFTER_DRAIN = false; EpiUV uv; EpiZXD zxd; EpiG gs;
    __device__ __forceinline__ void operator()(AccRef acc, const Unit& u, int wr, int wc, int fr, int fq) const {
        if (u.pn < 8) uv(acc, u, wr, wc, fr, fq);
        else if (u.pn < 29) { Unit v = u; v.pn = u.pn - 8; zxd(acc, v, wr, wc, fr, fq); }
        else { Unit v = u; v.pn = u.pn - 29; gs(acc, v, wr, wc, fr, fq); }
    }
};
struct EpiA {
    static constexpr bool PERM = true, AFTER_DRAIN = false; const bf16* GAB; const bf16* GABS; bf16* T;
    __device__ __forceinline__ void operator()(AccRef acc, const Unit& u, int wr, int wc, int fr, int fq) const {
        EPI_ROWS_BEGIN EPI_COLS_BEGIN
            float s[8]; unpack8(*(const u32x4*)((row < MP ? GAB + (size_t)row * 2048 : GABS + (size_t)(row - MP) * 2048) + col), s);
#pragma unroll
            for (int e = 0; e < 8; ++e) v[e] *= s[e];
            *(u32x4*)(T + (size_t)row * 1024 + col) = pack8(v);
        EPI_END EPI_END
    }
};
struct EpiB {
    static constexpr bool PERM = true, AFTER_DRAIN = false; const bf16* GAB; const bf16* GABS; const bf16* T; bf16* MG;
    __device__ __forceinline__ void operator()(AccRef acc, const Unit& u, int wr, int wc, int fr, int fq) const {
        EPI_ROWS_BEGIN EPI_COLS_BEGIN
            float s[8], t[8]; unpack8(*(const u32x4*)((row < MP ? GAB + (size_t)row * 2048 : GABS + (size_t)(row - MP) * 2048) + 1024 + col), s); unpack8(*(const u32x4*)(T + (size_t)row * 1024 + col), t);
#pragma unroll
            for (int e = 0; e < 8; ++e) v[e] = t[e] + s[e] * v[e];
            *(u32x4*)(MG + (size_t)row * 1024 + col) = pack8(v);
        EPI_END EPI_END
    }
};

struct EpiSq {
    static constexpr bool PERM = true, AFTER_DRAIN = false; bf16* O; float* ST;
    __device__ __forceinline__ void operator()(AccRef acc, const Unit& u, int wr, int wc, int fr, int fq) const {
        EPI_ROWS_BEGIN float s2 = 0.f;
            EPI_COLS_BEGIN
#pragma unroll
                for (int e = 0; e < 8; ++e) s2 += v[e] * v[e];
                *(u32x4*)(O + (size_t)row * 1024 + col) = pack8(v);
            EPI_END
            s2 += __shfl_xor(s2, 16); s2 += __shfl_xor(s2, 32);
            if (fq == 0) ST[(size_t)row * 16 + u.pn * 4 + wc] = s2;
        EPI_END
    }
};
struct EpiSqTail {
    static constexpr bool PERM = true, AFTER_DRAIN = false; EpiSq sq; float* SL; int kb_shift;
    __device__ __forceinline__ void operator()(AccRef acc, const Unit& u, int wr, int wc, int fr, int fq) const {
        if (u.nk == 0) { sq(acc, u, wr, wc, fr, fq); return; }
        float* base = SL + (size_t)(u.kb >> kb_shift) * (MS * D);
        EPI_ROWS_BEGIN EPI_COLS_BEGIN
            float* t = base + (size_t)(row - MP) * 1024 + col;
            *(f32x4*)t = (f32x4){v[0], v[1], v[2], v[3]}; *(f32x4*)(t + 4) = (f32x4){v[4], v[5], v[6], v[7]};
        EPI_END EPI_END
    }
};
struct EpiGen {
    static constexpr bool PERM = true, AFTER_DRAIN = false; int mode; const bf16* GAB; const bf16* T; bf16* O; float* ST; float* SL; int kb_shift;
    __device__ __forceinline__ void operator()(AccRef acc, const Unit& u, int wr, int wc, int fr, int fq) const {
        if (u.nk != 0) {
            bf16* base = (bf16*)SL + (size_t)(u.kb >> kb_shift) * (MS * D);
            EPI_ROWS_BEGIN EPI_COLS_BEGIN
                *(u32x4*)(base + (size_t)(row - MP) * 1024 + col) = pack8(v);
            EPI_END EPI_END
            return;
        }
        if (mode == 2) {
            EPI_ROWS_BEGIN float s2 = 0.f;
                EPI_COLS_BEGIN
#pragma unroll
                    for (int e = 0; e < 8; ++e) s2 += v[e] * v[e];
                    *(u32x4*)(O + (size_t)row * 1024 + col) = pack8(v);
                EPI_END
                s2 += __shfl_xor(s2, 16); s2 += __shfl_xor(s2, 32);
                if (fq == 0) ST[(size_t)row * 16 + u.pn * 4 + wc] = s2;
            EPI_END
            return;
        }
        if (mode == 3) {
            EPI_ROWS_BEGIN EPI_COLS_BEGIN
#pragma unroll
                for (int e = 0; e < 8; ++e) v[e] = fsigmoid(v[e]);
                *(u32x4*)(O + (size_t)row * 2048 + col) = pack8(v);
            EPI_END EPI_END
            return;
        }
        const int goff = mode ? 1024 : 0;
        EPI_ROWS_BEGIN EPI_COLS_BEGIN
            float s[8]; unpack8(*(const u32x4*)(GAB + (size_t)row * 2048 + goff + col), s);
            if (mode) { float t[8]; unpack8(*(const u32x4*)(T + (size_t)row * 1024 + col), t);
#pragma unroll
                for (int e = 0; e < 8; ++e) v[e] = t[e] + s[e] * v[e]; }
            else {
#pragma unroll
                for (int e = 0; e < 8; ++e) v[e] *= s[e]; }
            *(u32x4*)(O + (size_t)row * 1024 + col) = pack8(v);
        EPI_END EPI_END
    }
};
struct EpiUp {
    static constexpr bool PERM = true, AFTER_DRAIN = false; bf16* H;
    __device__ __forceinline__ void operator()(AccRef acc, const Unit& u, int wr, int wc, int fr, int fq) const {
        EPI_ROWS_BEGIN EPI_COLS_BEGIN
#pragma unroll
            for (int e = 0; e < 8; ++e) { const float r = fmaxf(v[e], 0.f); v[e] = r * r; }
            *(u32x4*)(H + (size_t)row * FF + col) = pack8(v);
        EPI_END EPI_END
    }
};

__device__ __forceinline__ void tr_item(const float* W, int K, int N, bf16* WT, const float* scale, bool winmap, LAS float* scr, int item, int lane) {
    const int nblk = N / 32, kb = item / nblk, nb = item % nblk, k0 = 64 * kb, n0 = 32 * nb;
    float wv[32];
#pragma unroll
    for (int i = 0; i < 32; ++i) wv[i] = __builtin_nontemporal_load(W + (size_t)(k0 + 2 * i + (lane >> 5)) * N + n0 + (lane & 31));
#pragma unroll
    for (int i = 0; i < 32; ++i) { const int kk = 2 * i + (lane >> 5); float v = wv[i]; if (scale) v *= scale[k0 + kk]; scr[kk * 33 + (lane & 31)] = v; }
    asm volatile("s_waitcnt lgkmcnt(0)" ::: "memory");
    const int c = lane & 7; const int rbase = (winmap && n0 >= 7200) ? n0 + 224 : n0;
#pragma unroll
    for (int j = 0; j < 4; ++j) { const int n = (lane >> 3) + 8 * j; const LAS float* s = scr + (8 * c) * 33 + n;
        u32x4 o; o.x = cvt_pk_bf16(s[0 * 33], s[1 * 33]); o.y = cvt_pk_bf16(s[2 * 33], s[3 * 33]); o.z = cvt_pk_bf16(s[4 * 33], s[5 * 33]); o.w = cvt_pk_bf16(s[6 * 33], s[7 * 33]);
        u32x4* dst = (u32x4*)(WT + (size_t)(rbase + n) * K + k0 + 8 * c);
        if (winmap) *dst = o; else __builtin_nontemporal_store(o, dst); }
    asm volatile("s_waitcnt lgkmcnt(0)" ::: "memory");
}
__device__ __forceinline__ void phase_prologue(const KP& p, LAS unsigned char* lds, int wid, int lane, int part, int gw_ = -1, int ngw_ = 0) {
    LAS float* scr = (LAS float*)(lds + wid * 16384);
    const int gw = gw_ >= 0 ? gw_ : blockIdx.x * 8 + wid, NGW = gw_ >= 0 ? ngw_ : gridDim.x * 8;
    constexpr int I_IN = 16 * 289, I_A = 16 * 32, I_B = 32 * 32, I_O = 16 * 32, I_UP = 16 * 128, I_DN = 64 * 32;
    constexpr int NITEMS = I_IN + I_A + I_B + I_O + I_UP + I_DN;
    unsigned char* ws = p.ws;
#pragma clang loop unroll(disable)
    for (int it = (part ? I_IN : 0) + gw; it < (part ? NITEMS : I_IN); it += NGW) {
        int r = it; const float* W; int K, N; bf16* WT; const float* sc = nullptr; bool wm = false;
        if (r < I_IN) { W = p.in[I_WIN]; K = D; N = NIN; WT = (bf16*)(ws + WS_WIN); sc = p.in[I_PREMIX]; wm = true; }
        else if ((r -= I_IN) < I_A) { W = p.in[I_WA]; K = D; N = D; WT = (bf16*)(ws + WS_WA); }
        else if ((r -= I_A) < I_B) { W = p.in[I_WB]; K = 2048; N = D; WT = (bf16*)(ws + WS_WB); }
        else if ((r -= I_B) < I_O) { W = p.in[I_WO]; K = D; N = D; WT = (bf16*)(ws + WS_WO); }
        else if ((r -= I_O) < I_UP) { W = p.in[I_WUP]; K = D; N = FF; WT = (bf16*)(ws + WS_WUP); sc = p.in[I_PREFFN]; }
        else { r -= I_UP; W = p.in[I_WDN]; K = FF; N = D; WT = (bf16*)(ws + WS_WDN); }
        tr_item(W, K, N, WT, sc, wm, scr, r, lane);
    }
    if (part) return;
    bf16* XN = (bf16*)(ws + WS_XN);
    for (int m = gw; m < M; m += NGW) {
        const f32x4* xr = (const f32x4*)xrow(p, m) + lane; f32x4 v[4]; float s = 0.f;
#pragma unroll
        for (int j = 0; j < 4; ++j) { v[j] = __builtin_nontemporal_load(xr + 64 * j); s += (v[j][0] * v[j][0] + v[j][1] * v[j][1]) + (v[j][2] * v[j][2] + v[j][3] * v[j][3]); }
        const float r = rsqrtf(wave_sum(s) * (1.f / D) + EPS);
        u32x2* o = (u32x2*)(XN + (size_t)m * D) + lane;
#pragma unroll
        for (int j = 0; j < 4; ++j) { u32x2 w; w.x = cvt_pk_bf16(v[j][0] * r, v[j][1] * r); w.y = cvt_pk_bf16(v[j][2] * r, v[j][3] * r); o[64 * j] = w; }
    }
}

__device__ __forceinline__ void gmlp_unit(const KP& p, LAS unsigned char* lds, int ck, int g, int tid, int wid, int lane, bool dry = false) {
    LAS bf16* Wl = (LAS bf16*)lds;
    LAS bf16* Vt = (LAS bf16*)(lds + 34816);
    LAS f32x2v* RS = (LAS f32x2v*)(lds + 69632);
    const bool sample = ck >= 128; const int nrows = sample ? 64 : 128; const int row0 = sample ? MP + (ck - 128) * 64 : ck * 128;
    bf16* U = (bf16*)(p.ws + WS_U); const bf16* G = (const bf16*)(p.ws + WS_G); const f32x2v* VST = (const f32x2v*)(p.ws + WS_VST);
    const float* Wg = p.in[I_GWS] + (size_t)g * 16384;
#pragma unroll
    for (int it = 0; it < 8; ++it) { const int idx = tid + it * NT; const int i = idx >> 5, j4 = (idx & 31) * 4; const f32x4 w = *(const f32x4*)(Wg + i * 128 + j4);
        u32x2 o; o.x = cvt_pk_bf16(w[0], w[1]); o.y = cvt_pk_bf16(w[2], w[3]); *(LAS u32x2*)(Wl + i * 136 + j4) = o; }
    if (tid < nrows) { const f32x2v* s = VST + (size_t)(row0 + tid) * 16; float a = 0.f, b = 0.f;
#pragma unroll
        for (int t = 0; t < 16; ++t) { const f32x2v x = s[t]; a += x.x; b += x.y; }
        const float mean = a * (1.f / 1024.f); const float var = fmaxf(b * (1.f / 1024.f) - mean * mean, 0.f); RS[tid] = (f32x2v){mean, rsqrtf(var + EPS)}; }
    __syncthreads();
    for (int it = tid; it < nrows * 16; it += NT) { const int j = it >> 4, d8 = (it & 15) * 8; const int c = g * 128 + d8;
        float x[8]; unpack8(*(const u32x4*)(G + (size_t)(row0 + j) * 1024 + c), x);
        const f32x2v rs = RS[j]; const f32x4 w0 = *(const f32x4*)(p.in[I_LNW] + c), w1 = *(const f32x4*)(p.in[I_LNW] + c + 4), b0 = *(const f32x4*)(p.in[I_LNB] + c), b1 = *(const f32x4*)(p.in[I_LNB] + c + 4);
        const float lw[8] = {w0[0], w0[1], w0[2], w0[3], w1[0], w1[1], w1[2], w1[3]}, lb[8] = {b0[0], b0[1], b0[2], b0[3], b1[0], b1[1], b1[2], b1[3]};
#pragma unroll
        for (int e = 0; e < 8; ++e) { x[e] = (x[e] - rs.x) * rs.y * lw[e] + lb[e]; Vt[(d8 + e) * 136 + j] = (bf16)(cvt_pk_bf16(x[e], 0.f) & 0xffffu); }
        if (sample && !dry) { float* o = p.out + O_VS + ((size_t)(ck - 128) * 64 + j) * 1024 + c; *(f32x4*)o = (f32x4){x[0], x[1], x[2], x[3]}; *(f32x4*)(o + 4) = (f32x4){x[4], x[5], x[6], x[7]}; }
    }
    __syncthreads();
    const int fr = lane & 15, q = lane >> 4; const int ibl = wid >> 1, ds0 = (wid & 1) * 4;
    f32x4 alo[4], ahi[4];
#pragma unroll
    for (int d = 0; d < 4; ++d) { alo[d] = (f32x4){0.f, 0.f, 0.f, 0.f}; ahi[d] = (f32x4){0.f, 0.f, 0.f, 0.f}; }
#pragma unroll
    for (int ks = 0; ks < 4; ++ks) {
        if (ks >= 2 && sample) break;
        bf16x8 X[4];
#pragma unroll
        for (int d = 0; d < 4; ++d) X[d] = *(const LAS bf16x8*)(Vt + ((ds0 + d) * 16 + fr) * 136 + ks * 32 + 8 * q);
        if (ks < 2) { const bf16x8 Y = *(const LAS bf16x8*)(Wl + (ibl * 16 + fr) * 136 + ks * 32 + 8 * q);
#pragma unroll
            for (int d = 0; d < 4; ++d) alo[d] = __builtin_amdgcn_mfma_f32_16x16x32_bf16(X[d], Y, alo[d], 0, 0, 0); }
        if (!sample) { const bf16x8 Y = *(const LAS bf16x8*)(Wl + ((4 + ibl) * 16 + fr) * 136 + ks * 32 + 8 * q);
#pragma unroll
            for (int d = 0; d < 4; ++d) ahi[d] = __builtin_amdgcn_mfma_f32_16x16x32_bf16(X[d], Y, ahi[d], 0, 0, 0); }
    }
#pragma unroll
    for (int hh = 0; hh < 2; ++hh) {
        if (hh == 1 && sample) break;
        const int i = (hh * 4 + ibl) * 16 + fr; const float bsv = p.in[I_GBS][g * 128 + i];
#pragma unroll
        for (int d = 0; d < 4; ++d) { const f32x4 a = hh ? ahi[d] : alo[d]; bf16* up = U + (size_t)(row0 + i) * 1024 + g * 128 + (ds0 + d) * 16 + 4 * q;
            const u32x2 uu = *(const u32x2*)up; u32x2 o; o.x = cvt_pk_bf16(bflo(uu.x) * (a[0] + bsv), bfhi(uu.x) * (a[1] + bsv)); o.y = cvt_pk_bf16(bflo(uu.y) * (a[2] + bsv), bfhi(uu.y) * (a[3] + bsv));
            if (!dry) *(u32x2*)up = o; }
    }
    __syncthreads();
}

__device__ __forceinline__ u32x4 ssd_load8(const KP& p, const bf16* XBC, int seq, int rowbase, int trel, int ch) {
    if (trel >= 0) return *(const u32x4*)(XBC + (size_t)(rowbase + trel) * 3072 + ch);
    if (seq >= 2) { const float* h = p.in[I_CACHE] + ((size_t)(seq - 2) * 3 + (trel + 3)) * 3072 + ch; const f32x4 a = *(const f32x4*)h, b = *(const f32x4*)(h + 4);
        return (u32x4){cvt_pk_bf16(a[0], a[1]), cvt_pk_bf16(a[2], a[3]), cvt_pk_bf16(b[0], b[1]), cvt_pk_bf16(b[2], b[3])}; }
    return (u32x4){0u, 0u, 0u, 0u};
}
__device__ __forceinline__ u32x2 ld8_agent(const bf16* q) { const unsigned long long v = __hip_atomic_load((const unsigned long long*)q, __ATOMIC_RELAXED, __HIP_MEMORY_SCOPE_AGENT); return (u32x2){(unsigned)v, (unsigned)(v >> 32)}; }
__device__ __forceinline__ void st8_agent(bf16* q, u32x2 w) { __hip_atomic_store((unsigned long long*)q, ((unsigned long long)w.y << 32) | w.x, __ATOMIC_RELAXED, __HIP_MEMORY_SCOPE_AGENT); }
template <bool WITH_Y, bool SAMPLE>
__device__ __forceinline__ void ssd_unit(const KP& p, LAS unsigned char* lds, int seq, int sc, int g, int tid, int wid, int lane, bool dry = false) {
    LAS bf16* XT = (LAS bf16*)lds;
    LAS bf16* BT = (LAS bf16*)(lds + 73728);
    LAS bf16* Cs = (LAS bf16*)(lds + 92160);
    LAS bf16* Bs = (LAS bf16*)(lds + 109568);
    LAS float* CBs = (LAS float*)(lds + 109568);
    LAS float* ACUM = (LAS float*)(lds + 126976);
    LAS float* DTL = ACUM + 512;
    LAS float* NP = DTL + 512;
    constexpr bool sample = SAMPLE; const int rowbase = sample ? MP + (seq - 2) * 64 : seq * 8192; constexpr int nch = sample ? 1 : 4; const int c0 = sc * 4;
    const int h = g * 8 + wid; const float a_h = -__expf(p.in[I_ALOG][h]); const float Dh = p.in[I_DSKIP][h];
    const int fr = lane & 15, q = lane >> 4;
    const bf16* XBC = (const bf16*)(p.ws + WS_XBC); const float* DT = (const float*)(p.ws + WS_DT);
    bf16* Zb = (bf16*)p.out; bf16* Sb = (bf16*)(p.ws + WS_S); float* CD = (float*)(p.ws + WS_CD);
    const float* cw = p.in[I_CONVW]; const float* cb = p.in[I_CONVB];
    u32x4 hs[4][4];
#pragma unroll
    for (int pb = 0; pb < 4; ++pb)
#pragma unroll
        for (int t = 0; t < 4; ++t) hs[pb][t] = (u32x4){0u, 0u, 0u, 0u};
    bf16* Sent = Sb + ((size_t)(seq * 32 + sc) * 32 + h) * 8192 + (size_t)fr * 128 + 4 * q;
    const float* Hin = p.in[I_STATE] + ((size_t)((sample ? seq - 2 : 0) * 32 + h) * 64 + fr) * 128 + 4 * q;
    float lastsum = 0.f;
#pragma unroll 1
    for (int cc = 0; cc < nch; ++cc) {
        const int cidx = c0 + cc; const int r0 = rowbase + cidx * 64;
        bf16* zrow = Zb + (size_t)(r0 + fr) * 2048 + h * 64 + 4 * q; bf16* sentc = Sent;
        asm volatile("" : "+v"(zrow), "+v"(sentc));
        const float dtv = DT[(size_t)(r0 + lane) * 32 + h];
        const int chl = wid * 64 + (lane & 7) * 8, j0 = (lane >> 3) * 8; int ch = g * 512 + chl;
        const int oct2 = tid & 31, seg2 = tid >> 5; const bool isC = oct2 >= 16; const bool bc_on = WITH_Y || !isC;
        const int nl = (oct2 & 15) * 8, j02 = seg2 * 4; int ch2 = 2048 + (isC ? 512 : 0) + g * 128 + nl;
        asm volatile("" : "+v"(ch), "+v"(ch2));
        u32x4 rawx[11], rawb[7];
#pragma unroll
        for (int r = 0; r < 11; ++r) rawx[r] = ssd_load8(p, XBC, seq, rowbase, cidx * 64 + j0 - 3 + r, ch);
        if (bc_on) {
#pragma unroll
            for (int r = 0; r < 7; ++r) rawb[r] = ssd_load8(p, XBC, seq, rowbase, cidx * 64 + j02 - 3 + r, ch2); }
        float acum = dtv * a_h;
#pragma unroll
        for (int o = 1; o < 64; o <<= 1) { const float t = __shfl_up(acum, o); if (lane >= o) acum += t; }
        const float last = __shfl(acum, 63);
        ACUM[wid * 64 + lane] = acum; DTL[wid * 64 + lane] = dtv;
        {
#pragma unroll
            for (int hf = 0; hf < 2; ++hf) {
                const int c4 = ch + 4 * hf;
                const f32x4 w0 = *(const f32x4*)(cw + c4), w1 = *(const f32x4*)(cw + 3072 + c4), w2 = *(const f32x4*)(cw + 6144 + c4), w3 = *(const f32x4*)(cw + 9216 + c4), bb = *(const f32x4*)(cb + c4);
                f32x4 x0, x1, x2, prev; unsigned pk[4][4];
#pragma unroll
                for (int r = 0; r < 11; ++r) {
                    const u32x4 rw = rawx[r];
                    const unsigned ra = hf ? rw.z : rw.x, rb = hf ? rw.w : rw.y; const f32x4 cur = (f32x4){bflo(ra), bfhi(ra), bflo(rb), bfhi(rb)};
                    if (r >= 3) { f32x4 t = bb + w0 * x0 + w1 * x1 + w2 * x2 + w3 * cur;
#pragma unroll
                        for (int e = 0; e < 4; ++e) t[e] = fsilu(t[e]);
                        if ((r - 3) & 1) {
#pragma unroll
                            for (int e = 0; e < 4; ++e) pk[e][(r - 3) >> 1] = cvt_pk_bf16(prev[e], t[e]); }
                        else prev = t; }
                    x0 = x1; x1 = x2; x2 = cur;
                }
#pragma unroll
                for (int e = 0; e < 4; ++e) *(LAS u32x4*)(XT + (size_t)(chl + 4 * hf + e) * 72 + j0) = (u32x4){pk[e][0], pk[e][1], pk[e][2], pk[e][3]};
                asm volatile("" ::: "memory");
            }
        }
        if (bc_on) {
#pragma unroll
            for (int hf = 0; hf < 2; ++hf) {
                const int c4 = ch2 + 4 * hf;
                const f32x4 w0 = *(const f32x4*)(cw + c4), w1 = *(const f32x4*)(cw + 3072 + c4), w2 = *(const f32x4*)(cw + 6144 + c4), w3 = *(const f32x4*)(cw + 9216 + c4), bb = *(const f32x4*)(cb + c4);
                f32x4 x0, x1, x2, o[4];
#pragma unroll
                for (int r = 0; r < 7; ++r) {
                    const unsigned ra = hf ? rawb[r].z : rawb[r].x, rb = hf ? rawb[r].w : rawb[r].y; const f32x4 cur = (f32x4){bflo(ra), bfhi(ra), bflo(rb), bfhi(rb)};
                    if (r >= 3) { f32x4 t = bb + w0 * x0 + w1 * x1 + w2 * x2 + w3 * cur;
#pragma unroll
                        for (int e = 0; e < 4; ++e) t[e] = fsilu(t[e]);
                        o[r - 3] = t; }
                    x0 = x1; x1 = x2; x2 = cur;
                }
                if (WITH_Y) {
#pragma unroll
                    for (int jj = 0; jj < 4; ++jj) *(LAS u32x2*)((isC ? Cs : Bs) + (j02 + jj) * 136 + nl + 4 * hf) = (u32x2){cvt_pk_bf16(o[jj][0], o[jj][1]), cvt_pk_bf16(o[jj][2], o[jj][3])};
                }
                if (!isC) {
#pragma unroll
                    for (int e = 0; e < 4; ++e) *(LAS u32x2*)(BT + (nl + 4 * hf + e) * 72 + j02) = (u32x2){cvt_pk_bf16(o[0][e], o[1][e]), cvt_pk_bf16(o[2][e], o[3][e])};
                }
                asm volatile("" ::: "memory");
            }
        }
        __syncthreads();
        LAS bf16* XTh = XT + wid * 64 * 72;
        if (WITH_Y) {
            const int ibc = wid >> 1, jb0 = (wid & 1) * 2; f32x4 cbt[2];
#pragma unroll
            for (int jt = 0; jt < 2; ++jt) { cbt[jt] = (f32x4){0.f, 0.f, 0.f, 0.f}; const int jb = jb0 + jt;
                if (jb <= ibc) {
#pragma unroll
                    for (int ks = 0; ks < 4; ++ks) { const bf16x8 X = *(const LAS bf16x8*)(Bs + (jb * 16 + fr) * 136 + ks * 32 + 8 * q), Y = *(const LAS bf16x8*)(Cs + (ibc * 16 + fr) * 136 + ks * 32 + 8 * q);
                        cbt[jt] = __builtin_amdgcn_mfma_f32_16x16x32_bf16(X, Y, cbt[jt], 0, 0, 0); } } }
            __syncthreads();
#pragma unroll
            for (int jt = 0; jt < 2; ++jt) *(LAS f32x4*)(CBs + (ibc * 16 + fr) * 68 + (jb0 + jt) * 16 + 4 * q) = cbt[jt];
            __syncthreads();
            f32x4 ya[4][4];
#pragma unroll
            for (int pb = 0; pb < 4; ++pb)
#pragma unroll
                for (int ib = 0; ib < 4; ++ib) ya[pb][ib] = (f32x4){0.f, 0.f, 0.f, 0.f};
#ifndef NO_YOFF
#pragma unroll
            for (int t = 0; t < 4; ++t) {
                u32x4 hf4[4];
#pragma unroll
                for (int pb = 0; pb < 4; ++pb) {
                    if (sample) { const f32x4 a = *(const f32x4*)(Hin + pb * 2048 + 32 * t), b = *(const f32x4*)(Hin + pb * 2048 + 32 * t + 16); hf4[pb] = (u32x4){cvt_pk_bf16(a[0], a[1]), cvt_pk_bf16(a[2], a[3]), cvt_pk_bf16(b[0], b[1]), cvt_pk_bf16(b[2], b[3])}; }
                    else { const u32x2 a = *(const u32x2*)(sentc + pb * 2048 + 32 * t), b = *(const u32x2*)(sentc + pb * 2048 + 32 * t + 16); hf4[pb] = (u32x4){a.x, a.y, b.x, b.y}; } }
#pragma unroll
                for (int ib = 0; ib < 4; ++ib) { const u32x2 ca = *(const LAS u32x2*)(Cs + (ib * 16 + fr) * 136 + 32 * t + 4 * q), cb2 = *(const LAS u32x2*)(Cs + (ib * 16 + fr) * 136 + 32 * t + 16 + 4 * q);
                    const bf16x8 Y = __builtin_bit_cast(bf16x8, ((u32x4){ca.x, ca.y, cb2.x, cb2.y}));
#pragma unroll
                    for (int pb = 0; pb < 4; ++pb) ya[pb][ib] = __builtin_amdgcn_mfma_f32_16x16x32_bf16(__builtin_bit_cast(bf16x8, hf4[pb]), Y, ya[pb][ib], 0, 0, 0); }
                asm volatile("" ::: "memory"); }
#pragma unroll
            for (int ib = 0; ib < 4; ++ib) { const float ea = __expf(ACUM[wid * 64 + ib * 16 + fr]);
#pragma unroll
                for (int pb = 0; pb < 4; ++pb) ya[pb][ib] = ya[pb][ib] * ea; }
#endif
            u32x2 zz[4][4];
#pragma unroll
            for (int ib = 0; ib < 4; ++ib)
#pragma unroll
                for (int pb = 0; pb < 4; ++pb) zz[ib][pb] = *(const u32x2*)(zrow + ib * 32768 + pb * 16);
#ifndef NO_YDIAG
#pragma unroll
            for (int ib = 0; ib < 4; ++ib)
#pragma unroll
                for (int ks = 0; ks < 2; ++ks) {
                    if (ks == 1 && ib < 2) continue;
                    const int i = ib * 16 + fr, js0 = ks * 32 + 8 * q; const float ai = ACUM[wid * 64 + i];
                    const f32x4 c0v = *(const LAS f32x4*)(CBs + i * 68 + js0), c1v = *(const LAS f32x4*)(CBs + i * 68 + js0 + 4);
                    const f32x4 a0 = *(const LAS f32x4*)(ACUM + wid * 64 + js0), a1 = *(const LAS f32x4*)(ACUM + wid * 64 + js0 + 4);
                    const f32x4 d0 = *(const LAS f32x4*)(DTL + wid * 64 + js0), d1 = *(const LAS f32x4*)(DTL + wid * 64 + js0 + 4);
                    float l[8];
#pragma unroll
                    for (int e = 0; e < 4; ++e) { l[e] = (js0 + e <= i) ? c0v[e] * __expf(ai - a0[e]) * d0[e] : 0.f; l[4 + e] = (js0 + 4 + e <= i) ? c1v[e] * __expf(ai - a1[e]) * d1[e] : 0.f; }
                    const bf16x8 Y = __builtin_bit_cast(bf16x8, pack8(l));
#pragma unroll
                    for (int pb = 0; pb < 4; ++pb) { const bf16x8 X = *(const LAS bf16x8*)(XTh + (pb * 16 + fr) * 72 + js0); ya[pb][ib] = __builtin_amdgcn_mfma_f32_16x16x32_bf16(X, Y, ya[pb][ib], 0, 0, 0); }
                    asm volatile("" ::: "memory");
                }
#endif
            float ss[4];
#pragma unroll
            for (int ib = 0; ib < 4; ++ib) { const int i = ib * 16 + fr; ss[ib] = 0.f;
#pragma unroll
                for (int pb = 0; pb < 4; ++pb) { const int pc = pb * 16 + 4 * q; const u32x2 z2 = zz[ib][pb];
                    const float zf[4] = {bflo(z2.x), bfhi(z2.x), bflo(z2.y), bfhi(z2.y)};
#pragma unroll
                    for (int jj = 0; jj < 4; ++jj) { const float xs = bf1(XTh[(pc + jj) * 72 + i]); const float gv = (ya[pb][ib][jj] + Dh * xs) * zf[jj]; ya[pb][ib][jj] = gv; ss[ib] += gv * gv; } }
                asm volatile("" ::: "memory");
                ss[ib] += __shfl_xor(ss[ib], 16); ss[ib] += __shfl_xor(ss[ib], 32);
                if (q == 0) NP[wid * 64 + i] = ss[ib]; }
            __syncthreads();
            f32x4 wv4[4];
#pragma unroll
            for (int pb = 0; pb < 4; ++pb) wv4[pb] = *(const f32x4*)(p.in[I_SNW] + h * 64 + pb * 16 + 4 * q);
#pragma unroll
            for (int ib = 0; ib < 4; ++ib) { const int i = ib * 16 + fr; float tot = 0.f;
#pragma unroll
                for (int w8 = 0; w8 < 8; ++w8) tot += NP[w8 * 64 + i];
                const float rstd = rsqrtf(tot * (1.f / 512.f) + EPS);
#pragma unroll
                for (int pb = 0; pb < 4; ++pb) { const int pc = pb * 16 + 4 * q; const f32x4 wv = wv4[pb];
                    float ov[4] = {ya[pb][ib][0] * rstd * wv[0], ya[pb][ib][1] * rstd * wv[1], ya[pb][ib][2] * rstd * wv[2], ya[pb][ib][3] * rstd * wv[3]};
#ifdef NAN_DBG
#pragma unroll
                    for (int e = 0; e < 4; ++e) ov[e] = (fabsf(ov[e]) < 1e30f) ? ov[e] : 0.f;
#endif
                    u32x2 o; o.x = cvt_pk_bf16(ov[0], ov[1]); o.y = cvt_pk_bf16(ov[2], ov[3]);
                    if (!dry) *(u32x2*)(zrow + ib * 32768 + pb * 16) = o; } }
        }
#ifndef NO_F
        if (!WITH_Y || sample || cc + 1 < nch) {
            const float e_last = __expf(last);
            bf16x8 Ys[4][2];
#pragma unroll
            for (int ks = 0; ks < 2; ++ks) { const int js0 = ks * 32 + 8 * q;
                const f32x4 a0 = *(const LAS f32x4*)(ACUM + wid * 64 + js0), a1 = *(const LAS f32x4*)(ACUM + wid * 64 + js0 + 4);
                const f32x4 d0 = *(const LAS f32x4*)(DTL + wid * 64 + js0), d1 = *(const LAS f32x4*)(DTL + wid * 64 + js0 + 4);
                float wj[8];
#pragma unroll
                for (int e = 0; e < 4; ++e) { wj[e] = d0[e] * __expf(last - a0[e]); wj[4 + e] = d1[e] * __expf(last - a1[e]); }
#pragma unroll
                for (int pb = 0; pb < 4; ++pb) { float x[8]; unpack8(*(const LAS u32x4*)(XTh + (pb * 16 + fr) * 72 + js0), x);
#pragma unroll
                    for (int e = 0; e < 8; ++e) x[e] *= wj[e];
                    Ys[pb][ks] = __builtin_bit_cast(bf16x8, pack8(x)); } }
#pragma unroll
            for (int t = 0; t < 4; ++t) {
                u32x2 oldp[2][4]; f32x4 olds[2][4];
#pragma unroll
                for (int hf = 0; hf < 2; ++hf)
#pragma unroll
                    for (int pb = 0; pb < 4; ++pb) {
                        if (sample) olds[hf][pb] = *(const f32x4*)(Hin + pb * 2048 + (2 * t + hf) * 16);
                        else if (WITH_Y) oldp[hf][pb] = *(const u32x2*)(sentc + pb * 2048 + (2 * t + hf) * 16); }
#pragma unroll
                for (int hf = 0; hf < 2; ++hf) { const int nb = 2 * t + hf;
                    const bf16x8 X0 = *(const LAS bf16x8*)(BT + (nb * 16 + fr) * 72 + 8 * q), X1 = *(const LAS bf16x8*)(BT + (nb * 16 + fr) * 72 + 32 + 8 * q);
#pragma unroll
                    for (int pb = 0; pb < 4; ++pb) {
                        f32x4 a;
                        if (sample) { a = olds[hf][pb] * e_last; }
                        else if (WITH_Y) { const u32x2 w = oldp[hf][pb]; a = (f32x4){bflo(w.x), bfhi(w.x), bflo(w.y), bfhi(w.y)} * e_last; }
                        else { const unsigned w0 = hf ? hs[pb][t].z : hs[pb][t].x, w1 = hf ? hs[pb][t].w : hs[pb][t].y; a = (f32x4){bflo(w0), bfhi(w0), bflo(w1), bfhi(w1)} * e_last; }
                        a = __builtin_amdgcn_mfma_f32_16x16x32_bf16(X0, Ys[pb][0], a, 0, 0, 0);
                        a = __builtin_amdgcn_mfma_f32_16x16x32_bf16(X1, Ys[pb][1], a, 0, 0, 0);
                        if (sample) { if (!dry) *(f32x4*)(p.out + O_SS + (((size_t)(seq - 2) * 32 + h) * 64 + pb * 16 + fr) * 128 + nb * 16 + 4 * q) = a; }
                        else if (WITH_Y) { if (!dry) *(u32x2*)(sentc + pb * 2048 + nb * 16) = (u32x2){cvt_pk_bf16(a[0], a[1]), cvt_pk_bf16(a[2], a[3])}; }
                        else { const unsigned w0 = cvt_pk_bf16(a[0], a[1]), w1 = cvt_pk_bf16(a[2], a[3]); if (hf) { hs[pb][t].z = w0; hs[pb][t].w = w1; } else { hs[pb][t].x = w0; hs[pb][t].y = w1; } }
                    } }
                asm volatile("" ::: "memory"); }
        }
#endif
        lastsum += last;
        __syncthreads();
    }
    if (!WITH_Y) {
#pragma unroll
        for (int pb = 0; pb < 4; ++pb)
#pragma unroll
            for (int t = 0; t < 4; ++t) { bf16* s0 = Sb + (((size_t)(seq * 32 + sc) * 32 + h) * 64 + pb * 16 + fr) * 128 + 32 * t + 4 * q;
                *(u32x2*)s0 = (u32x2){hs[pb][t].x, hs[pb][t].y}; *(u32x2*)(s0 + 16) = (u32x2){hs[pb][t].z, hs[pb][t].w}; }
        if (lane == 0) CD[(seq * 32 + sc) * 32 + h] = lastsum;
    }
}

__device__ __forceinline__ void phase_scan(const KP& p, int tid, bool dry = false) {
    asm volatile("" : "+v"(tid));
    const int gid = blockIdx.x * NT + tid;
    if (gid >= 131072) return;
    const int seq = gid >> 16, rem = gid & 65535, h = rem >> 11;
    bf16* Sb = (bf16*)(p.ws + WS_S); const float* CD = (const float*)(p.ws + WS_CD);
    f32x4 hv = (f32x4){0.f, 0.f, 0.f, 0.f};
    u32x2 sv[32]; float ev[32];
#pragma unroll
    for (int sc = 0; sc < 32; ++sc) { sv[sc] = *(const u32x2*)(Sb + (size_t)(seq * 32 + sc) * 262144 + (size_t)rem * 4); ev[sc] = CD[(seq * 32 + sc) * 32 + h]; }
#pragma unroll
    for (int sc = 0; sc < 32; ++sc) {
        u32x2* sp = (u32x2*)(Sb + (size_t)(seq * 32 + sc) * 262144 + (size_t)rem * 4);
        const u32x2 s = sv[sc]; const float e = __expf(ev[sc]);
        if (!dry) *sp = (u32x2){cvt_pk_bf16(hv[0], hv[1]), cvt_pk_bf16(hv[2], hv[3])};
        hv = hv * e + (f32x4){bflo(s.x), bfhi(s.x), bflo(s.y), bfhi(s.y)};
    }
    if (!dry) *(f32x4*)(p.out + O_SP + (size_t)seq * 262144 + (size_t)rem * 4) = hv;
}

__device__ __forceinline__ float load_row_sq(f32x4 (&t)[4], const bf16* O, const float* ST, const float* SL, int ns, int m, int lane) {
    float s = 0.f;
    if (m < MP) { const u32x2* r = (const u32x2*)(O + (size_t)m * D) + lane;
#pragma unroll
        for (int j = 0; j < 4; ++j) { const u32x2 w = r[64 * j]; t[j] = (f32x4){bflo(w.x), bfhi(w.x), bflo(w.y), bfhi(w.y)}; }
        s = lane < 16 ? ST[(size_t)m * 16 + lane] : 0.f;
    } else {
#pragma unroll
        for (int j = 0; j < 4; ++j) t[j] = (f32x4){0.f, 0.f, 0.f, 0.f};
        for (int k = 0; k < ns; ++k) { const u32x2* r = (const u32x2*)((const bf16*)SL + ((size_t)k * MS + (m - MP)) * D) + lane;
#pragma unroll
            for (int j = 0; j < 4; ++j) { const u32x2 w = r[64 * j]; t[j] = t[j] + (f32x4){bflo(w.x), bfhi(w.x), bflo(w.y), bfhi(w.y)}; } }
#pragma unroll
        for (int j = 0; j < 4; ++j) s += (t[j][0] * t[j][0] + t[j][1] * t[j][1]) + (t[j][2] * t[j][2] + t[j][3] * t[j][3]);
    }
    return wave_sum(s);
}
__device__ __forceinline__ void phase_mgs(const KP& p, int wid, int lane) {
    asm volatile("" : "+v"(lane));
    const int gw = blockIdx.x * 8 + wid, NGW = gridDim.x * 8;
    const float* SLA = (const float*)(p.ws + WS_SLA); const float* SLB = (const float*)(p.ws + WS_SLB); const bf16* GS = (const bf16*)(p.ws + WS_GABS); bf16* MG = (bf16*)(p.ws + WS_T);
    for (int m = gw; m < MS; m += NGW) {
#pragma unroll
        for (int j = 0; j < 4; ++j) { const int col = 4 * lane + 256 * j;
            const bf16* SA = (const bf16*)SLA; const bf16* SB = (const bf16*)SLB;
#define LDS4(P_, k_) ({ const u32x2 w_ = *(const u32x2*)((P_) + ((size_t)(k_) * MS + m) * D + col); (f32x4){bflo(w_.x), bfhi(w_.x), bflo(w_.y), bfhi(w_.y)}; })
            f32x4 pa = LDS4(SA, 0) + LDS4(SA, 1);
            f32x4 pb = (LDS4(SB, 0) + LDS4(SB, 1)) + (LDS4(SB, 2) + LDS4(SB, 3));
#undef LDS4
            const u32x2 a = *(const u32x2*)(GS + (size_t)m * 2048 + col), b = *(const u32x2*)(GS + (size_t)m * 2048 + 1024 + col);
            const f32x4 sa = (f32x4){bflo(a.x), bfhi(a.x), bflo(a.y), bfhi(a.y)}, sb = (f32x4){bflo(b.x), bfhi(b.x), bflo(b.y), bfhi(b.y)};
            const f32x4 o = sa * pa + sb * pb;
            *(u32x2*)(MG + (size_t)(MP + m) * D + col) = (u32x2){cvt_pk_bf16(o[0], o[1]), cvt_pk_bf16(o[2], o[3])}; }
    }
}
__device__ __forceinline__ void phase_x1(const KP& p, int wid, int lane) {
    asm volatile("" : "+v"(lane));
    const int gw = blockIdx.x * 8 + wid, NGW = gridDim.x * 8;
    bf16* X1N = (bf16*)(p.ws + WS_X1N);
    for (int m = gw; m < M; m += NGW) {
        f32x4 t[4]; const float rstd = rsqrtf(load_row_sq(t, (const bf16*)(p.ws + WS_T2), (const float*)(p.ws + WS_ST), (const float*)(p.ws + WS_ACO), 4, m, lane) * (1.f / D) + EPS);
        const f32x4* xr = (const f32x4*)xrow(p, m) + lane; const f32x4* wr4 = (const f32x4*)p.in[I_POSTMIX] + lane;
        f32x4 v[4]; float s2 = 0.f;
#pragma unroll
        for (int j = 0; j < 4; ++j) { v[j] = __builtin_nontemporal_load(xr + 64 * j) + t[j] * rstd * wr4[64 * j]; s2 += (v[j][0] * v[j][0] + v[j][1] * v[j][1]) + (v[j][2] * v[j][2] + v[j][3] * v[j][3]); }
        const float r2 = rsqrtf(wave_sum(s2) * (1.f / D) + EPS);
        f32x4* o = (f32x4*)(p.out + (size_t)m * D) + lane; u32x2* o2 = (u32x2*)(X1N + (size_t)m * D) + lane;
#pragma unroll
        for (int j = 0; j < 4; ++j) { __builtin_nontemporal_store(v[j], o + 64 * j); u32x2 w; w.x = cvt_pk_bf16(v[j][0] * r2, v[j][1] * r2); w.y = cvt_pk_bf16(v[j][2] * r2, v[j][3] * r2); o2[64 * j] = w; }
    }
}
__device__ __forceinline__ void phase_final(const KP& p, int wid, int lane) {
    asm volatile("" : "+v"(lane));
    const int gw = blockIdx.x * 8 + wid, NGW = gridDim.x * 8;
    for (int m = gw; m < M; m += NGW) {
        f32x4 t[4]; const float rstd = rsqrtf(load_row_sq(t, (const bf16*)(p.ws + WS_F), (const float*)(p.ws + WS_ST2), (const float*)(p.ws + WS_ACF), 8, m, lane) * (1.f / D) + EPS);
        f32x4* o = (f32x4*)(p.out + (size_t)m * D) + lane; const f32x4* wr4 = (const f32x4*)p.in[I_POSTFFN] + lane;
#pragma unroll
        for (int j = 0; j < 4; ++j) __builtin_nontemporal_store(o[64 * j] + t[j] * rstd * wr4[64 * j], o + 64 * j);
    }
}
__device__ __forceinline__ void zero_f32(float* q, int n4, int tid) {
    asm volatile("" : "+v"(tid));
    for (int i = blockIdx.x * NT + tid; i < n4; i += gridDim.x * NT) ((f32x4*)q)[i] = (f32x4){0.f, 0.f, 0.f, 0.f};
}

#define XB_TMO      128
#define XB_XCNT(j)  (256  + 64 * (j))
#define XB_XSUB(j)  (1280 + 64 * (j))
#define XB_XGEN(j)  (2304 + 64 * (j))
#define XB_TOP      3328
#define XB_TOPGEN   3392
#define XCD_BAR_WORDS 3456
#define XB_SPIN_CAP (1u << 18)

__device__ __forceinline__ unsigned xb_ld(unsigned* p)              { return __hip_atomic_load(p, __ATOMIC_RELAXED, __HIP_MEMORY_SCOPE_AGENT); }
__device__ __forceinline__ unsigned xb_add(unsigned* p, unsigned v) { return __hip_atomic_fetch_add(p, v, __ATOMIC_RELAXED, __HIP_MEMORY_SCOPE_AGENT); }
__device__ __forceinline__ unsigned xb_xcc_id() { return (unsigned)__builtin_amdgcn_s_getreg((3 << 11) | 20) & 0xFu; }
#define XB_SPIN(cond, bar) do { unsigned _sp = 0; while (cond) { __builtin_amdgcn_s_sleep(1); \
    if ((++_sp & 255u) == 0u) { if (xb_ld(&(bar)[XB_TMO])) break; if (_sp > XB_SPIN_CAP) { atomicAdd(&(bar)[XB_TMO], 1u); break; } } } } while (0)

struct XcdBarrier {
    unsigned* bar; unsigned x;
    volatile LAS unsigned* st;
};

__device__ __forceinline__ XcdBarrier xcd_barrier_post(unsigned* bar, volatile LAS unsigned* st) {
    XcdBarrier b; b.bar = bar; b.x = xb_xcc_id(); b.st = st;
    if (threadIdx.x == 0) (void)xb_add(&bar[XB_XCNT(b.x)], 1u);
    return b;
}
__device__ __forceinline__ void xcd_barrier_complete(unsigned* bar, unsigned x, unsigned& nloc, unsigned& nx) {
    const unsigned G = gridDim.x * gridDim.y * gridDim.z;
    unsigned sum, cnt, mine, sp = 0u;
    for (;;) {
        sum = 0u; cnt = 0u; mine = 0u;
#pragma unroll
        for (unsigned j = 0; j < 16; ++j) { const unsigned c = xb_ld(&bar[XB_XCNT(j)]); sum += c; cnt += (c > 0u) ? 1u : 0u; mine = (j == x) ? c : mine; }
        if (sum == G) break;
        __builtin_amdgcn_s_sleep(1);
        if ((++sp & 255u) == 0u) { if (xb_ld(&bar[XB_TMO])) break; if (sp > XB_SPIN_CAP) { atomicAdd(&bar[XB_TMO], 1u); break; } }
    }
    nloc = mine > 0u ? mine : 1u; nx = cnt > 0u ? cnt : 1u;
}

__device__ __forceinline__ void xcd_barrier(const XcdBarrier& b) {
    asm volatile("s_waitcnt vmcnt(0)" ::: "memory");
    __syncthreads();
    if (threadIdx.x == 0) {
        unsigned* bar = b.bar;
        __builtin_amdgcn_s_waitcnt(0);
        unsigned nloc = b.st[0], nx = b.st[1];
        if (nloc == 0u) { xcd_barrier_complete(bar, b.x, nloc, nx); b.st[0] = nloc; b.st[1] = nx; }
        const unsigned old = xb_add(&bar[XB_XSUB(b.x)], 1u);
        const unsigned gen = old / nloc;
        if (old + 1u == (gen + 1u) * nloc) {
            __builtin_amdgcn_fence(__ATOMIC_RELEASE, "agent");
            asm volatile("s_waitcnt vmcnt(0)" ::: "memory");
            const unsigned og = xb_add(&bar[XB_TOP], 1u);
            const unsigned tg = og / nx;
            if (og + 1u == (tg + 1u) * nx) xb_add(&bar[XB_TOPGEN], 1u);
            else XB_SPIN(xb_ld(&bar[XB_TOPGEN]) == tg, bar);
            __builtin_amdgcn_fence(__ATOMIC_ACQUIRE, "agent");
            xb_add(&bar[XB_XGEN(b.x)], 1u);
            asm volatile("s_waitcnt vmcnt(0)" ::: "memory");
        } else {
            XB_SPIN(xb_ld(&bar[XB_XGEN(b.x)]) == gen, bar);
            __builtin_amdgcn_fence(__ATOMIC_ACQUIRE, "agent");
            asm volatile("s_waitcnt vmcnt(0)" ::: "memory");
        }
    }
    __syncthreads();
}

constexpr int NPHASE = 14;
__global__ void __launch_bounds__(NT, 2) hybrid_fwd(KP p) {
#define RELOAD_P() do { } while (0)
    extern __shared__ __attribute__((aligned(16))) unsigned char lds_raw[];
    LAS unsigned char* lds = (LAS unsigned char*)lds_raw;
    const int tid = threadIdx.x, lane = tid & 63, wid = __builtin_amdgcn_readfirstlane(tid >> 6);
    const int G = gridDim.x, c = blockIdx.x;
    unsigned char* ws = p.ws;
    const int lo = p.ph_lo, hi = p.ph_hi;
#ifndef PHMASK
#define PHMASK 0x7fff
#endif
#if MK_LAUNCHES == 1
#define IN(k) (((PHMASK >> (k)) & 1) != 0)
#else
#define IN(k) (((PHMASK >> (k)) & 1) && lo <= (k) && (k) < hi)
#endif
#ifndef DUPMASK
#define DUPMASK 0
#endif
#define REP(k) for (int rep_ = 0; rep_ < (((DUPMASK >> (k)) & 1) ? 2 : 1); ++rep_)
#if MK_LAUNCHES == 1
#define SEAM(k) do { if (IN(k) && IN((k) + 1)) xcd_barrier(xbar); } while (0)
#else
#define SEAM(k) do { } while (0)
#endif
    volatile LAS unsigned* xst = (volatile LAS unsigned*)(lds + LDS_BYTES - 64);
    if (tid < 2) xst[tid] = 0u;
    __syncthreads();
    XcdBarrier xbar; xbar.bar = (unsigned*)ws; xbar.x = 0; xbar.st = xst;
#if MK_LAUNCHES == 1
    xbar = xcd_barrier_post((unsigned*)ws, xst);
#endif
    if (hi < 0) cg::this_grid().sync();
    bf16* Win = (bf16*)(ws + WS_WIN);
    RELOAD_P();
    if (IN(0)) phase_prologue(p, lds, wid, lane, 0);
    SEAM(0);
    RELOAD_P();
    if (IN(1)) {
        pg8::Gemm g{(const bf16*)(ws + WS_XN), Win, M, 7424, D}; pg8::InOrder S; S.init(M, 7424, G, c);
        EpiIn E{EpiUV{(bf16*)(ws + WS_U), (bf16*)(ws + WS_G), (f32x2v*)(ws + WS_VST)}, EpiZXD{(bf16*)p.out, (bf16*)(ws + WS_XBC), (float*)(ws + WS_DT), p.in[I_DTB], p.out}, EpiG{(bf16*)(ws + WS_GABS), MP}};
        pg8::gemm_phase<EpiIn, pg8::InOrder, true, true>(lds, g, S, E);
    }
    SEAM(1);
    RELOAD_P();
    if (IN(2)) {
        if (c < 64) { ssd_unit<true, true>(p, lds, 2 + (c >> 2), 0, c & 3, tid, wid, lane);
            for (int u = c; u < 128; u += 64) gmlp_unit(p, lds, u >> 3, u & 7, tid, wid, lane); }
        else { for (int u = 128 + (c - 64); u < 144 * 8; u += G - 64) gmlp_unit(p, lds, u >> 3, u & 7, tid, wid, lane);
            phase_prologue(p, lds, wid, lane, 1, (c - 64) * 8 + wid, (G - 64) * 8); }
    }
    SEAM(2);
    RELOAD_P();
    if (IN(3)) { for (int u = c; u < 256; u += G) ssd_unit<false, false>(p, lds, u >> 7, (u >> 2) & 31, u & 3, tid, wid, lane); }
    SEAM(3);
    RELOAD_P();
    if (IN(4)) phase_scan(p, tid);
    SEAM(4);
    RELOAD_P();
    if (IN(5)) { for (int u = c; u < 256; u += G) ssd_unit<true, false>(p, lds, u >> 7, (u >> 2) & 31, u & 3, tid, wid, lane); }
    SEAM(5);
#pragma clang loop unroll(disable)
    for (int ph = 6; ph <= 13; ++ph) {
        RELOAD_P();
        if (IN(ph)) {
            if (ph == 9) phase_mgs(p, wid, lane);
            else if (ph == 11) phase_x1(p, wid, lane);
            else if (ph == 12) {
                pg8::Gemm g{(const bf16*)(ws + WS_X1N), (const bf16*)(ws + WS_WUP), M, FF, D}; pg8::StaticOrder S; S.init(M, FF, G, c);
                EpiUp E{(bf16*)(ws + WS_H)};
                pg8::gemm_phase<EpiUp, pg8::StaticOrder, true, true>(lds, g, S, E);
            } else {
                const bf16* A; const bf16* B; int K, log_ns, nk, gate = 0; EpiGen E; E.GAB = (const bf16*)(ws + WS_GAB); E.T = (const bf16*)(ws + WS_T); E.ST = (float*)(ws + WS_ST);
                if (ph == 6)       { A = (const bf16*)(ws + WS_XN); B = Win + (size_t)7424 * D;     K = D;    log_ns = 0; nk = 0; E.mode = 3; E.O = (bf16*)(ws + WS_GAB); E.SL = nullptr; E.kb_shift = 0; gate = 1; }
                else if (ph == 7)  { A = (const bf16*)(ws + WS_U);  B = (const bf16*)(ws + WS_WA);  K = D;    log_ns = 1; nk = 8; E.mode = 0; E.O = (bf16*)(ws + WS_T);  E.SL = (float*)(ws + WS_SLA); E.kb_shift = 10; }
                else if (ph == 8)  { A = (const bf16*)p.out;        B = (const bf16*)(ws + WS_WB);  K = 2048; log_ns = 2; nk = 8; E.mode = 1; E.O = (bf16*)(ws + WS_T);  E.SL = (float*)(ws + WS_SLB); E.kb_shift = 10; }
                else if (ph == 10) { A = (const bf16*)(ws + WS_T);  B = (const bf16*)(ws + WS_WO);  K = D;    log_ns = 2; nk = 4; E.mode = 2; E.O = (bf16*)(ws + WS_T2); E.SL = (float*)(ws + WS_ACO); E.kb_shift = 9; }
                else               { A = (const bf16*)(ws + WS_H);  B = (const bf16*)(ws + WS_WDN); K = FF;   log_ns = 3; nk = 8; E.mode = 2; E.O = (bf16*)(ws + WS_F);  E.SL = (float*)(ws + WS_ACF); E.kb_shift = 10; }
                pg8::Gemm g{A, B, M, D, K}; pg8::TailOrder S; S.init(log_ns, nk, G, c, gate, ph == 8 ? 32 : 0);
                pg8::gemm_phase<EpiGen, pg8::TailOrder, true, true>(lds, g, S, E);
            }
        }
        if (ph == 6 || ph == 7) __syncthreads();
        else if (IN(ph) && IN(ph + 1)) xcd_barrier(xbar);
    }
    RELOAD_P();
    if (IN(14)) phase_final(p, wid, lane);
#undef IN
#undef SEAM
#undef RELOAD_P
}

extern "C" void kernel_launch(void* const* d_in, const int* in_sizes, int n_in, void* d_out, int out_size, void* d_ws, size_t ws_size, hipStream_t stream) {
    static int grid = 0;
    if (grid == 0) {
        if (n_in != 24 || ws_size < WS_END) { fprintf(stderr, "kernel_launch: unexpected n_in %d / ws_size %zu\n", n_in, ws_size); grid = -1; return; }
        int dev = 0, cus = 0, per_cu = 0;
        hipGetDevice(&dev); hipDeviceGetAttribute(&cus, hipDeviceAttributeMultiprocessorCount, dev);
        hipFuncSetAttribute((const void*)hybrid_fwd, hipFuncAttributeMaxDynamicSharedMemorySize, LDS_BYTES);
        hipOccupancyMaxActiveBlocksPerMultiprocessor(&per_cu, (const void*)hybrid_fwd, NT, LDS_BYTES);
        (void)hipGetLastError();
        if (per_cu < 1) fprintf(stderr, "kernel_launch: occupancy query says %d blocks/CU\n", per_cu);
        grid = cus;
    }
    if (grid < 0) return;
    KP a{};
    for (int i = 0; i < 24; ++i) a.in[i] = (const float*)d_in[i];
    a.out = (float*)d_out; a.ws = (unsigned char*)d_ws;
#if MK_LAUNCHES == 1
    (void)hipMemsetAsync(d_ws, 0, 16384, stream);
    a.ph_lo = 0; a.ph_hi = NPHASE + 1;
    void* args[] = {&a};
    hipError_t e = hipLaunchCooperativeKernel((const void*)hybrid_fwd, dim3(grid), dim3(NT), args, LDS_BYTES, stream);
    if (e != hipSuccess) fprintf(stderr, "cooperative launch failed: %s (grid %d)\n", hipGetErrorString(e), grid);
#else
#ifndef LASTPH
#define LASTPH NPHASE
#endif
    for (int k = 0; k <= LASTPH; ++k) { a.ph_lo = k; a.ph_hi = k + 1; hipLaunchKernelGGL(hybrid_fwd, dim3(grid), dim3(NT), LDS_BYTES, stream, a); }
#endif
}
```
